# Optimizing an MI355X kernel written in HIP

```python
import jax, jax.numpy as jnp
from jax import lax
import numpy as np

D_MODEL = 2048
BATCH = 4
SEQ = 4096
DEPTH = 2

CHUNK = 64
D_RNN = 2048
LRU_BLOCKS = 8
LRU_BLOCK_W = D_RNN // LRU_BLOCKS
LRU_C = 8.0
CONV_A_WIDTH = 4
D_CONV = 2048
CONV_B_WIDTH = 3
D_FF = 4 * D_MODEL
EPS = 1e-6

SPLIT_SIZES = (D_RNN, D_RNN, D_CONV, D_CONV, D_CONV, D_MODEL, D_MODEL)
SPLIT_POINTS = tuple(int(v) for v in np.cumsum(SPLIT_SIZES)[:-1])
N_IN = int(sum(SPLIT_SIZES))

kernel_name = "hybrid_rglru_shortconv_gated_trunk"


def _rmsnorm(x, g):
    xf = x.astype(jnp.float32)
    y = xf * lax.rsqrt(jnp.mean(xf * xf, axis=-1, keepdims=True) + EPS)
    return (y * g.astype(jnp.float32)).astype(x.dtype)


def _causal_dwconv(x, w):
    k, c = w.shape
    return lax.conv_general_dilated(
        x, w[:, None, :].astype(x.dtype), window_strides=(1,), padding=[(k - 1, 0)],
        dimension_numbers=("NWC", "WIO", "NWC"), feature_group_count=c)


def _lru_combine(left, right):
    a_l, b_l = left
    a_r, b_r = right
    return a_l * a_r, a_r * b_l + b_r


def _rg_lru(x, wr, br, wi, bi, lam):
    bsz, s, c = x.shape
    xb = x.reshape(bsz, s, LRU_BLOCKS, LRU_BLOCK_W)
    r = jax.nn.sigmoid(jnp.einsum("bsnh,nhk->bsnk", xb, wr) + br).reshape(bsz, s, c)
    i = jax.nn.sigmoid(jnp.einsum("bsnh,nhk->bsnk", xb, wi) + bi).reshape(bsz, s, c)
    log_a = -LRU_C * r.astype(jnp.float32) * jax.nn.softplus(-lam.astype(jnp.float32))
    a = jnp.exp(log_a)
    mult = jnp.sqrt(-jnp.expm1(2.0 * log_a))
    b = mult * (i * x).astype(jnp.float32)
    _, h = lax.associative_scan(_lru_combine, (a, b), axis=1)
    return h.astype(x.dtype)


def _layer(x, g1, w_in, b_in, conv_a_w, conv_a_b, lru_wr, lru_br, lru_wi, lru_bi, lru_lam,
           conv_b_w, w_pa, w_pb, w_o, g2, w_mlp1, w_mlp2):
    h = _rmsnorm(x, g1)
    z = jnp.einsum("bsd,dn->bsn", h, w_in) + b_in
    xa, ya, cb, cc, cx, ga, gb = jnp.split(z, SPLIT_POINTS, axis=-1)
    xa = _causal_dwconv(xa, conv_a_w) + conv_a_b
    xa = _rg_lru(xa, lru_wr, lru_br, lru_wi, lru_bi, lru_lam)
    out_a = jnp.einsum("bsc,cd->bsd", xa * jax.nn.gelu(ya), w_pa)
    out_b = jnp.einsum("bsc,cd->bsd", cb * _causal_dwconv(cc * cx, conv_b_w), w_pb)
    merged = jax.nn.sigmoid(ga) * out_a + jax.nn.sigmoid(gb) * out_b
    x = x + jnp.einsum("bsd,de->bse", merged, w_o)
    h2 = _rmsnorm(x, g2)
    u = jnp.square(jax.nn.relu(jnp.einsum("bsd,df->bsf", h2, w_mlp1)))
    return x + jnp.einsum("bsf,fd->bsd", u, w_mlp2)


def setup_inputs(seed: int = 0) -> dict:
    key = jax.random.key(seed)
    ks = jax.random.split(key, 24)
    f32 = jnp.float32
    L = DEPTH

    def nrm(k, shape, scale):
        return jax.random.normal(k, shape, f32) * scale

    u = jax.random.uniform(ks[10], (L, D_RNN), f32, minval=0.9, maxval=0.999)
    p = u ** (1.0 / LRU_C)
    lru_lam = jnp.log(p) - jnp.log1p(-p)
    return {
        "x": nrm(ks[0], (BATCH, SEQ, D_MODEL), 1.0),
        "norm1_g": 1.0 + nrm(ks[1], (L, D_MODEL), 0.02),
        "w_in": nrm(ks[2], (L, D_MODEL, N_IN), D_MODEL ** -0.5),
        "b_in": nrm(ks[3], (L, N_IN), 0.02),
        "conv_a_w": nrm(ks[4], (L, CONV_A_WIDTH, D_RNN), CONV_A_WIDTH ** -0.5),
        "conv_a_b": nrm(ks[5], (L, D_RNN), 0.02),
        "lru_wr": nrm(ks[6], (L, LRU_BLOCKS, LRU_BLOCK_W, LRU_BLOCK_W), LRU_BLOCK_W ** -0.5),
        "lru_br": nrm(ks[7], (L, LRU_BLOCKS, LRU_BLOCK_W), 0.02),
        "lru_wi": nrm(ks[8], (L, LRU_BLOCKS, LRU_BLOCK_W, LRU_BLOCK_W), LRU_BLOCK_W ** -0.5),
        "lru_bi": nrm(ks[9], (L, LRU_BLOCKS, LRU_BLOCK_W), 0.02),
        "lru_lam": lru_lam,
        "conv_b_w": nrm(ks[11], (L, CONV_B_WIDTH, D_CONV), CONV_B_WIDTH ** -0.5),
        "w_pa": nrm(ks[12], (L, D_RNN, D_MODEL), D_RNN ** -0.5),
        "w_pb": nrm(ks[13], (L, D_CONV, D_MODEL), D_CONV ** -0.5),
        "w_o": nrm(ks[14], (L, D_MODEL, D_MODEL), D_MODEL ** -0.5),
        "norm2_g": 1.0 + nrm(ks[15], (L, D_MODEL), 0.02),
        "w_mlp1": nrm(ks[16], (L, D_MODEL, D_FF), D_MODEL ** -0.5),
        "w_mlp2": nrm(ks[17], (L, D_FF, D_MODEL), D_FF ** -0.5),
        "final_g": 1.0 + nrm(ks[18], (D_MODEL,), 0.02),
    }


def reference(x, norm1_g, w_in, b_in, conv_a_w, conv_a_b, lru_wr, lru_br, lru_wi, lru_bi,
              lru_lam, conv_b_w, w_pa, w_pb, w_o, norm2_g, w_mlp1, w_mlp2, final_g):
    for l in range(DEPTH):
        x = _layer(x, norm1_g[l], w_in[l], b_in[l], conv_a_w[l], conv_a_b[l], lru_wr[l], lru_br[l],
                   lru_wi[l], lru_bi[l], lru_lam[l], conv_b_w[l], w_pa[l], w_pb[l], w_o[l],
                   norm2_g[l], w_mlp1[l], w_mlp2[l])
    return _rmsnorm(x, final_g)
```

```cpp
#include <hip/hip_runtime.h>
#include <hip/hip_cooperative_groups.h>
#include <cstdio>
#include <cstdint>
namespace cg = cooperative_groups;

#define LAS __attribute__((address_space(3)))
typedef unsigned short bf16_t;
typedef short bf16x8 __attribute__((ext_vector_type(8)));
typedef float f32x4 __attribute__((ext_vector_type(4)));
typedef float f32x2 __attribute__((ext_vector_type(2)));
typedef unsigned u32x4 __attribute__((ext_vector_type(4)));
typedef unsigned u32x2 __attribute__((ext_vector_type(2)));

constexpr int M = 16384, D = 2048, NIN = 14336, FF = 8192, SEQ = 4096, DEPTH = 2;
constexpr float EPS = 1e-6f;
constexpr float LOG2E = 1.4426950408889634f;

constexpr size_t MiB = 1u << 20;
constexpr size_t WS_SS = 65536;
constexpr size_t WS_C8 = 1 * MiB;
constexpr size_t WS_W = 2 * MiB, LW = 146 * MiB;
constexpr size_t OW_IN = 0, OW_G = 56 * MiB, OW_PA = 58 * MiB, OW_PB = 66 * MiB, OW_O = 74 * MiB, OW_1 = 82 * MiB, OW_2 = 114 * MiB;
constexpr size_t WS_Z = 296 * MiB;
constexpr size_t SEC = (size_t)M * D;
constexpr size_t WS_H = 744 * MiB;
constexpr size_t WS_B = 808 * MiB;
constexpr size_t WS_AGG = 872 * MiB;
constexpr size_t WS_SSP = 876 * MiB;
constexpr size_t WS_END = 880 * MiB;

constexpr int LDS_BYTES = 147456;
constexpr int REP_P0 = 1, REP_R = 1, REP_G1 = 1, REP_G2 = 1, REP_S1 = 1, REP_G6 = 1, REP_BAR = 1, REP_S3 = 1, REP_CA = 1;

__device__ __forceinline__ unsigned cvt_pk_bf16(float lo, float hi) { unsigned r; asm volatile("v_cvt_pk_bf16_f32 %0, %1, %2" : "=v"(r) : "v"(lo), "v"(hi)); return r; }
__device__ __forceinline__ float bf_lo(unsigned w) { return __uint_as_float(w << 16); }
__device__ __forceinline__ float bf_hi(unsigned w) { return __uint_as_float(w & 0xffff0000u); }
__device__ __forceinline__ float fast_sigmoid(float v) { return __builtin_amdgcn_rcpf(1.0f + __builtin_amdgcn_exp2f(-LOG2E * v)); }
__device__ __forceinline__ float gelu_tanh(float v) {
    const float t = v * (1.0f + 0.044715f * v * v);
    return v * __builtin_amdgcn_rcpf(1.0f + __builtin_amdgcn_exp2f(-2.0f * 0.7978845608028654f * LOG2E * t));
}
__device__ __forceinline__ float rstd_of(const float* ssp, int row) {
    const f32x4 a = *(const f32x4*)(ssp + (size_t)row * 8), b = *(const f32x4*)(ssp + (size_t)row * 8 + 4);
    return rsqrtf((((a.x + a.y) + (a.z + a.w)) + ((b.x + b.y) + (b.z + b.w))) * (1.f / D) + EPS);
}
__device__ __forceinline__ void rstd8(float (&r)[8], const float* ssp, int row0) {
#pragma unroll
    for (int h = 0; h < 2; ++h) {
        f32x4 a[4], b[4];
#pragma unroll
        for (int q = 0; q < 4; ++q) { const size_t o = (size_t)(row0 + h * 128 + q * 16) * 8; a[q] = *(const f32x4*)(ssp + o); b[q] = *(const f32x4*)(ssp + o + 4); }
#pragma unroll
        for (int q = 0; q < 4; ++q) r[h * 4 + q] = rsqrtf((((a[q].x + a[q].y) + (a[q].z + a[q].w)) + ((b[q].x + b[q].y) + (b[q].z + b[q].w))) * (1.f / D) + EPS);
    }
}
__device__ __forceinline__ void rstd8_cached(float (&r)[8], const float* ssp, int tag, int pm, LAS float* rl, int wr, int wc, int fr, int fq) {
    const int cur = ((volatile LAS int*)rl)[0];
    if (cur != tag) {
        asm volatile("s_waitcnt lgkmcnt(0)" ::: "memory"); __builtin_amdgcn_s_barrier(); asm volatile("" ::: "memory");
        const int t = (wr * 4 + wc) * 64 + fq * 16 + fr;
        if (t < 256) { const size_t o = (size_t)(pm * 256 + t) * 8; const f32x4 a = *(const f32x4*)(ssp + o), b = *(const f32x4*)(ssp + o + 4);
            rl[64 + t] = rsqrtf((((a.x + a.y) + (a.z + a.w)) + ((b.x + b.y) + (b.z + b.w))) * (1.f / D) + EPS);
            if (t == 0) ((LAS int*)rl)[0] = tag; }
        asm volatile("s_waitcnt lgkmcnt(0)" ::: "memory"); __builtin_amdgcn_s_barrier(); asm volatile("" ::: "memory");
    }
#pragma unroll
    for (int q = 0; q < 8; ++q) r[q] = rl[64 + (q >> 2) * 128 + wr * 64 + (q & 3) * 16 + fr];
}
__device__ __forceinline__ float wave_sum(float v) {
#pragma unroll
    for (int o = 1; o < 64; o <<= 1) v += __shfl_xor(v, o);
    return v;
}
#define LDS_WAIT() asm volatile("s_waitcnt lgkmcnt(0)" ::: "memory")
__device__ __forceinline__ int lane_id() { int l; asm volatile("v_mbcnt_lo_u32_b32 %0, -1, 0\n\tv_mbcnt_hi_u32_b32 %0, -1, %0" : "=v"(l)); return l; }


#define XB_TMO      128
#define XB_XCNT(j)  (256  + 64 * (j))
#define XB_XSUB(j)  (1280 + 64 * (j))
#define XB_XGEN(j)  (2304 + 64 * (j))
#define XB_TOP      3328
#define XB_TOPGEN   3392
#define XCD_BAR_WORDS 3456
#define XB_SPIN_CAP (1u << 22)
__device__ __forceinline__ unsigned xb_ld(unsigned* p)              { return __hip_atomic_load(p, __ATOMIC_RELAXED, __HIP_MEMORY_SCOPE_AGENT); }
__device__ __forceinline__ unsigned xb_add(unsigned* p, unsigned v) { return __hip_atomic_fetch_add(p, v, __ATOMIC_RELAXED, __HIP_MEMORY_SCOPE_AGENT); }
__device__ __forceinline__ unsigned xb_xcc_id() { return (unsigned)__builtin_amdgcn_s_getreg((3 << 11) | 20) & 0xFu; }
#define XB_SPIN(cond, bar) do { unsigned _sp = 0; while (cond) { __builtin_amdgcn_s_sleep(1); \
    if ((++_sp & 255u) == 0u) { if (xb_ld(&(bar)[XB_TMO])) break; if (_sp > XB_SPIN_CAP) { atomicAdd(&(bar)[XB_TMO], 1u); break; } } } } while (0)
struct XcdBarrier { unsigned* bar; unsigned x; volatile LAS unsigned* st; int wave; };
__device__ __forceinline__ XcdBarrier xcd_barrier_post(unsigned* bar, volatile LAS unsigned* st) {
    XcdBarrier b; b.bar = bar; b.x = xb_xcc_id(); b.st = st; b.wave = 0;
    return b;
}
__device__ __forceinline__ void xcd_barrier_complete(unsigned* bar, unsigned x, unsigned& nloc, unsigned& nx) {
    const unsigned G = gridDim.x * gridDim.y * gridDim.z;
    unsigned sum, cnt, mine, sp = 0u;
    for (;;) {
        sum = 0u; cnt = 0u; mine = 0u;
#pragma unroll
        for (unsigned j = 0; j < 16; ++j) { const unsigned c = xb_ld(&bar[XB_XCNT(j)]); sum += c; cnt += (c > 0u) ? 1u : 0u; mine = (j == x) ? c : mine; }
        if (sum == G) break;
        __builtin_amdgcn_s_sleep(1);
        if ((++sp & 255u) == 0u) { if (xb_ld(&bar[XB_TMO])) break; if (sp > XB_SPIN_CAP) { atomicAdd(&bar[XB_TMO], 1u); break; } }
    }
    nloc = mine > 0u ? mine : 1u; nx = cnt > 0u ? cnt : 1u;
}
__device__ __forceinline__ void xcd_barrier(const XcdBarrier& b) {
    asm volatile("s_waitcnt vmcnt(0)" ::: "memory");
    __syncthreads();
    if (b.wave == 0 && lane_id() == 0) {
        unsigned* bar = b.bar;
        __builtin_amdgcn_s_waitcnt(0);
        unsigned nloc = b.st[0], nx = b.st[1];
        if (nloc == 0u) { xcd_barrier_complete(bar, b.x, nloc, nx); b.st[0] = nloc; b.st[1] = nx; }
        const unsigned old = xb_add(&bar[XB_XSUB(b.x)], 1u);
        const unsigned gen = old / nloc;
        if (old + 1u == (gen + 1u) * nloc) {
            __builtin_amdgcn_fence(__ATOMIC_RELEASE, "agent");
            asm volatile("s_waitcnt vmcnt(0)" ::: "memory");
            const unsigned og = xb_add(&bar[XB_TOP], 1u);
            const unsigned tg = og / nx;
            if (og + 1u == (tg + 1u) * nx) xb_add(&bar[XB_TOPGEN], 1u);
            else XB_SPIN(xb_ld(&bar[XB_TOPGEN]) == tg, bar);
            __builtin_amdgcn_fence(__ATOMIC_ACQUIRE, "agent");
            xb_add(&bar[XB_XGEN(b.x)], 1u);
            asm volatile("s_waitcnt vmcnt(0)" ::: "memory");
        } else {
            XB_SPIN(xb_ld(&bar[XB_XGEN(b.x)]) == gen, bar);
            __builtin_amdgcn_fence(__ATOMIC_ACQUIRE, "agent");
            asm volatile("s_waitcnt vmcnt(0)" ::: "memory");
        }
    }
    __syncthreads();
}

#define XB_LSUB(j)  (4096 + 64 * (j))
#define XB_LGEN(j)  (5120 + 64 * (j))
__device__ __forceinline__ void xcd_local_barrier(const XcdBarrier& b) {
    asm volatile("s_waitcnt vmcnt(0)" ::: "memory");
    __syncthreads();
    if (b.wave == 0 && lane_id() == 0) {
        unsigned* bar = b.bar;
        __builtin_amdgcn_s_waitcnt(0);
        const unsigned nloc = b.st[0];
        const unsigned old = xb_add(&bar[XB_LSUB(b.x)], 1u);
        const unsigned gen = old / nloc;
        if (old + 1u == (gen + 1u) * nloc) xb_add(&bar[XB_LGEN(b.x)], 1u);
        else XB_SPIN(xb_ld(&bar[XB_LGEN(b.x)]) == gen, bar);
        __builtin_amdgcn_fence(__ATOMIC_ACQUIRE, "agent");
        asm volatile("s_waitcnt vmcnt(0)" ::: "memory");
    }
    __syncthreads();
}

namespace pg8 {
constexpr int BM = 256, BK = 64, HALF = 128, HTB = HALF * BK * 2, STAGE_BYTES = 8 * HTB, NXCD = 8, WGM = 4;
__host__ __device__ __forceinline__ int lds_byte(int r, int c) { const int st = (r >> 4) * 2 + (c >> 5), rr = r & 15, cc = c & 31, ob = rr * 64 + cc * 2; return st * 1024 + (ob ^ (((ob >> 9) & 1) << 5)); }
__host__ __device__ __forceinline__ void stage_rc(int b, int& R, int& C) { const int st = b / 1024, sb = b % 1024, swz = sb ^ (((sb >> 9) & 1) << 5); R = (st >> 1) * 16 + swz / 64; C = (st & 1) * 32 + (swz % 64) / 2; }
__host__ __device__ __forceinline__ int perm32(int rho) { const int n = rho >> 4, i = rho & 15; return 8 * (i >> 2) + 4 * n + (i & 3); }

struct Unit { int pm, pn; };
struct Gemm { const bf16_t* A; const bf16_t* Bt; int lda, K, ash, amul; const bf16_t* A2; const bf16_t* Bt2; };

struct StaticOrder {
    int nM, nN, nwg, G, c; bool revr; bool pmajor;
    __device__ void init(int M_, int N_, int G_, int c_, bool pmajor_ = false) { nM = M_ / BM; nN = N_ / BM; nwg = nM * nN; G = G_; c = c_; pmajor = pmajor_; revr = false; }
    __device__ bool next(int i, Unit& u) const {
        if ((long)i * G + c >= nwg) return false;
        const int nR = nwg / G; const int ii = (revr && nwg % G == 0) ? (nR - 1 - i) : i;
        const long L = (long)ii * G + c;
        int wgid = (int)L; { const int q = nwg / NXCD, r = nwg % NXCD, xcd = wgid % NXCD, off = wgid / NXCD; wgid = (xcd < r ? xcd * (q + 1) : r * (q + 1) + (xcd - r) * q) + off; }
        const int nig = WGM * nN, gid = wgid / nig, fm = gid * WGM, gsz = (nM - fm) < WGM ? (nM - fm) : WGM;
        const int w = wgid % nig;
        if (pmajor) { u.pn = w % nN; u.pm = fm + w / nN; } else { u.pm = fm + (w % gsz); u.pn = w / gsz; }
        return true;
    }
};

template <class Epi, int NSEG = 1>
__device__ __forceinline__ void gemm_phase(LAS unsigned char* lds, const Gemm g, const StaticOrder& S, const Epi& E, int wave_s) {
    int tid = wave_s * 64 + lane_id(); asm volatile("" : "+v"(tid));
    const int wid = __builtin_amdgcn_readfirstlane(tid >> 6), lane = tid & 63, wr = wid >> 2, wc = wid & 3, fr = lane & 15, fq = lane >> 4;
    const int K = g.K, nt = K / BK, lda = g.lda;
    unsigned voffA[2], voffB[2];
#pragma unroll
    for (int i = 0; i < 2; ++i) { int R, C; stage_rc(tid * 16 + i * 8192, R, C); const int Rb = Epi::PERM ? ((R & ~31) + perm32(R & 31)) : R;
        voffA[i] = (unsigned)(R * lda + C) * 2u; voffB[i] = (unsigned)(Rb * K + C) * 2u; }
    const size_t kstep = (size_t)(BK * 2);
    const size_t hstepA = (size_t)HALF * lda * 2, hstepB = (size_t)HALF * K * 2;
    const size_t tstepA = 2 * hstepA, tstepB = 2 * hstepB;
    const unsigned ldsw = (unsigned)wid * 1024u;
    const int aoff = lds_byte(wr * 64 + fr, fq * 8), boff = lds_byte(wc * 32 + fr, fq * 8);
#define PG8_SA(b, h) (((b) * 2 + (h)) * HTB)
#define PG8_SB(b, h) ((4 + (b) * 2 + (h)) * HTB)
#define PG8_STAGE(bufoff, gbase, voff) do { _Pragma("unroll") for (int _i = 0; _i < 2; ++_i) \
        __builtin_amdgcn_global_load_lds((const unsigned*)((const char*)(gbase) + (voff)[_i]), (LAS unsigned*)(lds + (bufoff) + ldsw + _i * 8192), 16, 0, 0); } while (0)
#define PG8_LDA(dst, b, h) do { _Pragma("unroll") for (int m = 0; m < 4; ++m) _Pragma("unroll") for (int k = 0; k < 2; ++k) dst[m][k] = *(const LAS bf16x8*)(lds + PG8_SA(b, h) + aoff + m * 2048 + k * 1024); } while (0)
#define PG8_LDB(dst, b, h) do { _Pragma("unroll") for (int n = 0; n < 2; ++n) _Pragma("unroll") for (int k = 0; k < 2; ++k) dst[n][k] = *(const LAS bf16x8*)(lds + PG8_SB(b, h) + boff + n * 2048 + k * 1024); } while (0)
#define PG8_MMA(ai, bj, At, Bt) do { __builtin_amdgcn_s_setprio(1); _Pragma("unroll") for (int m = 0; m < 4; ++m) _Pragma("unroll") for (int n = 0; n < 2; ++n) _Pragma("unroll") for (int k = 0; k < 2; ++k) \
        acc[ai][bj][m][n] = __builtin_amdgcn_mfma_f32_16x16x32_bf16(Bt[n][k], At[m][k], acc[ai][bj][m][n], 0, 0, 0); __builtin_amdgcn_s_setprio(0); } while (0)
#define PG8_WAIT_V(n) asm volatile("s_waitcnt vmcnt(" #n ")" ::: "memory")
#define PG8_WAIT_L(n) asm volatile("s_waitcnt lgkmcnt(" #n ")" ::: "memory")
#define PG8_BAR __builtin_amdgcn_s_barrier()
#define PG8_SCHED __builtin_amdgcn_sched_barrier(0)
    Unit cur, nxt; int ui = 0;
    if (!S.next(0, cur)) return;
    f32x4 acc[2][2][4][2];
#pragma unroll
    for (int a = 0; a < 2; ++a)
#pragma unroll
        for (int b = 0; b < 2; ++b)
#pragma unroll
            for (int m = 0; m < 4; ++m)
#pragma unroll
                for (int n = 0; n < 2; ++n) acc[a][b][m][n] = (f32x4){0.f, 0.f, 0.f, 0.f};
    bf16x8 At[4][2], B0[2][2], B1[2][2];
    const char* cA = (const char*)g.A + (size_t)cur.pm * tstepA + (size_t)((cur.pn >> g.ash) * g.amul) * 2; const char* cB = (const char*)g.Bt + (size_t)cur.pn * tstepB;
    PG8_STAGE(PG8_SB(0, 0), cB, voffB); PG8_STAGE(PG8_SB(0, 1), cB + hstepB, voffB); PG8_STAGE(PG8_SA(0, 0), cA, voffA); PG8_STAGE(PG8_SA(0, 1), cA + hstepA, voffA);
    if (wr == 1) PG8_BAR;
    PG8_WAIT_V(2); PG8_BAR;
    PG8_STAGE(PG8_SB(1, 0), cB + kstep, voffB); PG8_STAGE(PG8_SA(1, 0), cA + kstep, voffA); PG8_STAGE(PG8_SB(1, 1), cB + hstepB + kstep, voffB);
    PG8_WAIT_V(6); PG8_BAR;
#define PG8_KLOOP() do { \
        _Pragma("unroll 1") \
        for (int t = 0; t < nt; t += 2) { \
            const bool last = (t == nt - 2); \
            const char* a1 = cA + (size_t)(t + 1) * kstep; \
            const char* a2 = last ? nA : cA + (size_t)(t + 2) * kstep; const char* b2 = last ? nB : cB + (size_t)(t + 2) * kstep; \
            const char* a3 = a2 + kstep; const char* b3 = b2 + kstep; \
            PG8_LDB(B0, 0, 0); PG8_LDB(B1, 0, 1); PG8_SCHED; PG8_LDA(At, 0, 0); PG8_STAGE(PG8_SA(1, 1), a1 + hstepA, voffA); \
            PG8_WAIT_V(8); PG8_WAIT_L(0); PG8_BAR; PG8_MMA(0, 0, At, B0); PG8_MMA(0, 1, At, B1); PG8_BAR; PG8_SCHED; \
            PG8_LDA(At, 0, 1); PG8_STAGE(PG8_SB(0, 0), b2, voffB); PG8_STAGE(PG8_SB(0, 1), b2 + hstepB, voffB); PG8_STAGE(PG8_SA(0, 0), a2, voffA); \
            PG8_WAIT_V(8); PG8_WAIT_L(0); PG8_BAR; PG8_MMA(1, 0, At, B0); PG8_MMA(1, 1, At, B1); PG8_BAR; PG8_SCHED; \
            PG8_LDB(B0, 1, 0); PG8_LDB(B1, 1, 1); PG8_SCHED; PG8_LDA(At, 1, 0); PG8_STAGE(PG8_SA(0, 1), a2 + hstepA, voffA); \
            PG8_WAIT_V(8); PG8_WAIT_L(0); PG8_BAR; PG8_MMA(0, 0, At, B0); PG8_MMA(0, 1, At, B1); PG8_BAR; PG8_SCHED; \
            PG8_LDA(At, 1, 1); PG8_STAGE(PG8_SB(1, 0), b3, voffB); PG8_STAGE(PG8_SB(1, 1), b3 + hstepB, voffB); PG8_STAGE(PG8_SA(1, 0), a3, voffA); \
            PG8_WAIT_V(8); PG8_WAIT_L(0); PG8_BAR; PG8_MMA(1, 0, At, B0); PG8_MMA(1, 1, At, B1); PG8_BAR; PG8_SCHED; \
        } \
    } while (0)
    for (;;) {
        if constexpr (NSEG > 1) {
            const char* nA = (const char*)g.A2 + (size_t)cur.pm * tstepA + (size_t)((cur.pn >> g.ash) * g.amul) * 2; const char* nB = (const char*)g.Bt2 + (size_t)cur.pn * tstepB;
            PG8_KLOOP();
            if (wr == 0) PG8_BAR;
            E.mid(acc, cur, wr, wc, fr, fq);
            cA = nA; cB = nB;
            if (wr == 1) PG8_BAR;
        }
        const bool has_next = S.next(ui + 1, nxt);
        const char* nA = has_next ? (const char*)g.A + (size_t)nxt.pm * tstepA + (size_t)((nxt.pn >> g.ash) * g.amul) * 2 : cA; const char* nB = has_next ? (const char*)g.Bt + (size_t)nxt.pn * tstepB : cB;
        PG8_KLOOP();
        if (wr == 0) PG8_BAR;
        E(acc, cur, wr, wc, fr, fq);
        if (!has_next) break;
#pragma unroll
        for (int a = 0; a < 2; ++a)
#pragma unroll
            for (int b = 0; b < 2; ++b)
#pragma unroll
                for (int m = 0; m < 4; ++m)
#pragma unroll
                    for (int n = 0; n < 2; ++n) acc[a][b][m][n] = (f32x4){0.f, 0.f, 0.f, 0.f};
        cur = nxt; cA = nA; cB = nB; ++ui;
        if (wr == 1) PG8_BAR;
    }
    PG8_WAIT_V(0);
    PG8_BAR;
#undef PG8_KLOOP
#undef PG8_SA
#undef PG8_SB
#undef PG8_STAGE
#undef PG8_LDA
#undef PG8_LDB
#undef PG8_MMA
#undef PG8_WAIT_V
#undef PG8_WAIT_L
#undef PG8_BAR
#undef PG8_SCHED
}
}
using pg8::Unit;

typedef f32x4 AccT[2][2][4][2];

struct EpiIn {
    static constexpr bool PERM = true;
    bf16_t* Z; const float* bias; const float* ss; int stage; LAS float* rl;
    __device__ __forceinline__ void operator()(const AccT& acc, const Unit& u, int wr, int wc, int fr, int fq) const {
        const int row0 = u.pm * 256 + wr * 64 + fr;
        float rs[8]; rstd8_cached(rs, ss, (stage << 8) | u.pm, u.pm, rl, wr, wc, fr, fq);
        if (u.pn >= 24 && u.pn < 40) {
            const int ch0 = (u.pn - 24) * 128 + wc * 32 + 8 * fq;
            f32x4 bc[2], bx[2];
#pragma unroll
            for (int n = 0; n < 2; ++n) { bc[n] = *(const f32x4*)(bias + 3 * D + ch0 + 4 * n); bx[n] = *(const f32x4*)(bias + 4 * D + ch0 + 4 * n); }
            bf16_t* base = Z + 3 * SEC;
#pragma unroll
            for (int ai = 0; ai < 2; ++ai)
#pragma unroll
                for (int m = 0; m < 4; ++m) { const int row = row0 + ai * 128 + m * 16;
                    const float rstd = rs[ai * 4 + m];
                    const f32x4 v0 = (acc[ai][0][m][0] * rstd + bc[0]) * (acc[ai][1][m][0] * rstd + bx[0]), v1 = (acc[ai][0][m][1] * rstd + bc[1]) * (acc[ai][1][m][1] * rstd + bx[1]);
                    u32x4 w; w.x = cvt_pk_bf16(v0[0], v0[1]); w.y = cvt_pk_bf16(v0[2], v0[3]); w.z = cvt_pk_bf16(v1[0], v1[1]); w.w = cvt_pk_bf16(v1[2], v1[3]);
                    *(u32x4*)(base + (size_t)row * D + ch0) = w; }
            return;
        }
        if (u.pn >= 40) {
            const int ch0 = (u.pn - 40) * 128 + wc * 32 + 8 * fq;
            f32x4 ba[2], bb[2];
#pragma unroll
            for (int n = 0; n < 2; ++n) { ba[n] = *(const f32x4*)(bias + 5 * D + ch0 + 4 * n); bb[n] = *(const f32x4*)(bias + 6 * D + ch0 + 4 * n); }
#pragma unroll
            for (int ai = 0; ai < 2; ++ai)
#pragma unroll
                for (int m = 0; m < 4; ++m) { const int row = row0 + ai * 128 + m * 16;
                    const float rstd = rs[ai * 4 + m];
                    f32x4 rt[2], sb[2];
#pragma unroll
                    for (int n = 0; n < 2; ++n)
#pragma unroll
                        for (int j = 0; j < 4; ++j) { const float ea = __builtin_amdgcn_exp2f(-LOG2E * (acc[ai][0][m][n][j] * rstd + ba[n][j])), eb = __builtin_amdgcn_exp2f(-LOG2E * (acc[ai][1][m][n][j] * rstd + bb[n][j]));
                            const float pa = 1.0f + ea, pb = 1.0f + eb, q = __builtin_amdgcn_rcpf(pa * pb);
                            sb[n][j] = pa * q; rt[n][j] = pb * pb * q; }
                    u32x4 w; w.x = cvt_pk_bf16(rt[0][0], rt[0][1]); w.y = cvt_pk_bf16(rt[0][2], rt[0][3]); w.z = cvt_pk_bf16(rt[1][0], rt[1][1]); w.w = cvt_pk_bf16(rt[1][2], rt[1][3]);
                    *(u32x4*)(Z + 5 * SEC + (size_t)row * D + ch0) = w;
                    u32x4 v; v.x = cvt_pk_bf16(sb[0][0], sb[0][1]); v.y = cvt_pk_bf16(sb[0][2], sb[0][3]); v.z = cvt_pk_bf16(sb[1][0], sb[1][1]); v.w = cvt_pk_bf16(sb[1][2], sb[1][3]);
                    *(u32x4*)(Z + 6 * SEC + (size_t)row * D + ch0) = v; }
            return;
        }
        const int s = u.pn >> 3; const int colt = (u.pn & 7) * 256;
        bf16_t* base = Z + (size_t)s * SEC;
        const int col0 = colt + wc * 32 + 8 * fq, bcol0 = s * D + col0;
        f32x4 bv[2][2];
#pragma unroll
        for (int bj = 0; bj < 2; ++bj)
#pragma unroll
            for (int n = 0; n < 2; ++n) bv[bj][n] = *(const f32x4*)(bias + bcol0 + bj * 128 + 4 * n);
#pragma unroll
        for (int ai = 0; ai < 2; ++ai)
#pragma unroll
            for (int m = 0; m < 4; ++m) { bf16_t* rowp = base + (size_t)(row0 + ai * 128 + m * 16) * D + col0;
                const float rstd = rs[ai * 4 + m];
#pragma unroll
                for (int bj = 0; bj < 2; ++bj) { f32x4 v0 = acc[ai][bj][m][0] * rstd + bv[bj][0], v1 = acc[ai][bj][m][1] * rstd + bv[bj][1];
                    u32x4 w; w.x = cvt_pk_bf16(v0[0], v0[1]); w.y = cvt_pk_bf16(v0[2], v0[3]); w.z = cvt_pk_bf16(v1[0], v1[1]); w.w = cvt_pk_bf16(v1[2], v1[3]);
                    *(u32x4*)(rowp + bj * 128) = w; } }
    }
};

struct EpiGate {
    static constexpr bool PERM = true;
    const bf16_t* XC; bf16_t* LA; bf16_t* BV; const float* br; const float* bi; const float* c8p;
    __device__ __forceinline__ void operator()(const AccT& acc, const Unit& u, int wr, int wc, int fr, int fq) const {
        const int row0 = u.pm * 256 + wr * 64 + fr, ch0 = u.pn * 128 + wc * 32 + 8 * fq;
        f32x4 brv[2], biv[2], c8[2];
#pragma unroll
        for (int n = 0; n < 2; ++n) { brv[n] = *(const f32x4*)(br + ch0 + 4 * n); biv[n] = *(const f32x4*)(bi + ch0 + 4 * n); c8[n] = *(const f32x4*)(c8p + ch0 + 4 * n); }
        u32x4 xw4[8];
#pragma unroll
        for (int q = 0; q < 8; ++q) xw4[q] = *(const u32x4*)(XC + (size_t)(row0 + (q >> 2) * 128 + (q & 3) * 16) * D + ch0);
#pragma unroll
        for (int ai = 0; ai < 2; ++ai)
#pragma unroll
            for (int m = 0; m < 4; ++m) { const size_t off = (size_t)(row0 + ai * 128 + m * 16) * D + ch0;
                const u32x4 xq = xw4[ai * 4 + m];
                const float xv[8] = {bf_lo(xq.x), bf_hi(xq.x), bf_lo(xq.y), bf_hi(xq.y), bf_lo(xq.z), bf_hi(xq.z), bf_lo(xq.w), bf_hi(xq.w)};
                float lo[8], bo[8];
#pragma unroll
                for (int n = 0; n < 2; ++n)
#pragma unroll
                    for (int j = 0; j < 4; ++j) { const float er = 1.0f + __builtin_amdgcn_exp2f(-LOG2E * (acc[ai][0][m][n][j] + brv[n][j])), ei = 1.0f + __builtin_amdgcn_exp2f(-LOG2E * (acc[ai][1][m][n][j] + biv[n][j]));
                        const float qq = __builtin_amdgcn_rcpf(er * ei), r = ei * qq, ig = er * qq;
                        const float la = c8[n][j] * r; const float a2 = __builtin_amdgcn_exp2f(2.0f * la);
                        const float mult = __builtin_amdgcn_sqrtf(fmaxf(1.0f - a2, 0.0f));
                        lo[n * 4 + j] = la; bo[n * 4 + j] = mult * ig * xv[n * 4 + j]; }
                u32x4 w; w.x = cvt_pk_bf16(lo[0], lo[1]); w.y = cvt_pk_bf16(lo[2], lo[3]); w.z = cvt_pk_bf16(lo[4], lo[5]); w.w = cvt_pk_bf16(lo[6], lo[7]);
                *(u32x4*)(LA + off) = w;
                u32x4 v; v.x = cvt_pk_bf16(bo[0], bo[1]); v.y = cvt_pk_bf16(bo[2], bo[3]); v.z = cvt_pk_bf16(bo[4], bo[5]); v.w = cvt_pk_bf16(bo[6], bo[7]);
                *(u32x4*)(BV + off) = v; }
    }
};

struct EpiMerge2 {
    static constexpr bool PERM = true;
    bf16_t* RT; const bf16_t* GB;
    __device__ __forceinline__ void mid(AccT& acc, const Unit& u, int wr, int wc, int fr, int fq) const {
        const int row0 = u.pm * 256 + wr * 64 + fr, col0 = u.pn * 256 + wc * 32 + 8 * fq;
#pragma unroll
        for (int ai = 0; ai < 2; ++ai) {
            u32x4 rw[4][2];
#pragma unroll
            for (int m = 0; m < 4; ++m)
#pragma unroll
                for (int bj = 0; bj < 2; ++bj) rw[m][bj] = *(const u32x4*)(RT + (size_t)(row0 + ai * 128 + m * 16) * D + col0 + bj * 128);
#pragma unroll
            for (int m = 0; m < 4; ++m)
#pragma unroll
                for (int bj = 0; bj < 2; ++bj) { const u32x4 r = rw[m][bj];
                    acc[ai][bj][m][0] *= (f32x4){bf_lo(r.x), bf_hi(r.x), bf_lo(r.y), bf_hi(r.y)}; acc[ai][bj][m][1] *= (f32x4){bf_lo(r.z), bf_hi(r.z), bf_lo(r.w), bf_hi(r.w)}; }
        }
    }
    __device__ __forceinline__ void operator()(const AccT& acc, const Unit& u, int wr, int wc, int fr, int fq) const {
        const int row0 = u.pm * 256 + wr * 64 + fr, col0 = u.pn * 256 + wc * 32 + 8 * fq;
#pragma unroll
        for (int ai = 0; ai < 2; ++ai) {
            u32x4 gb[4][2];
#pragma unroll
            for (int m = 0; m < 4; ++m)
#pragma unroll
                for (int bj = 0; bj < 2; ++bj) gb[m][bj] = __builtin_nontemporal_load((const u32x4*)(GB + (size_t)(row0 + ai * 128 + m * 16) * D + col0 + bj * 128));
#pragma unroll
            for (int m = 0; m < 4; ++m)
#pragma unroll
                for (int bj = 0; bj < 2; ++bj) { const u32x4 b = gb[m][bj];
                    const f32x4 v0 = acc[ai][bj][m][0] * (f32x4){bf_lo(b.x), bf_hi(b.x), bf_lo(b.y), bf_hi(b.y)}, v1 = acc[ai][bj][m][1] * (f32x4){bf_lo(b.z), bf_hi(b.z), bf_lo(b.w), bf_hi(b.w)};
                    u32x4 w; w.x = cvt_pk_bf16(v0[0], v0[1]); w.y = cvt_pk_bf16(v0[2], v0[3]); w.z = cvt_pk_bf16(v1[0], v1[1]); w.w = cvt_pk_bf16(v1[2], v1[3]);
                    *(u32x4*)(RT + (size_t)(row0 + ai * 128 + m * 16) * D + col0 + bj * 128) = w; }
        }
    }
};

struct EpiResid {
    static constexpr bool PERM = true;
    const void* base; void* out; float* ss; bool base_bf16, out_f32; LAS float* red;
    __device__ __forceinline__ void operator()(const AccT& acc, const Unit& u, int wr, int wc, int fr, int fq) const {
        const int row0 = u.pm * 256 + wr * 64 + fr, col0 = u.pn * 256 + wc * 32 + 8 * fq;
#pragma unroll
        for (int ai = 0; ai < 2; ++ai) {
            f32x4 bs[4][2][2];
            if (base_bf16) {
                const bf16_t* bp = (const bf16_t*)base;
                u32x4 raw[4][2];
#pragma unroll
                for (int m = 0; m < 4; ++m)
#pragma unroll
                    for (int bj = 0; bj < 2; ++bj) raw[m][bj] = *(const u32x4*)(bp + (size_t)(row0 + ai * 128 + m * 16) * D + col0 + bj * 128);
#pragma unroll
                for (int m = 0; m < 4; ++m)
#pragma unroll
                    for (int bj = 0; bj < 2; ++bj) { const u32x4 r = raw[m][bj]; bs[m][bj][0] = (f32x4){bf_lo(r.x), bf_hi(r.x), bf_lo(r.y), bf_hi(r.y)}; bs[m][bj][1] = (f32x4){bf_lo(r.z), bf_hi(r.z), bf_lo(r.w), bf_hi(r.w)}; }
            } else {
                const float* bp = (const float*)base;
#pragma unroll
                for (int m = 0; m < 4; ++m)
#pragma unroll
                    for (int bj = 0; bj < 2; ++bj) { const size_t off = (size_t)(row0 + ai * 128 + m * 16) * D + col0 + bj * 128; bs[m][bj][0] = *(const f32x4*)(bp + off); bs[m][bj][1] = *(const f32x4*)(bp + off + 4); }
            }
#pragma unroll
            for (int m = 0; m < 4; ++m) { const int row = row0 + ai * 128 + m * 16; const size_t off = (size_t)row * D + col0; float sq = 0.f;
#pragma unroll
                for (int bj = 0; bj < 2; ++bj) {
                    const f32x4 v0 = bs[m][bj][0] + acc[ai][bj][m][0], v1 = bs[m][bj][1] + acc[ai][bj][m][1];
                    sq += (v0[0] * v0[0] + v0[1] * v0[1]) + (v0[2] * v0[2] + v0[3] * v0[3]) + (v1[0] * v1[0] + v1[1] * v1[1]) + (v1[2] * v1[2] + v1[3] * v1[3]);
                    if (out_f32) { float* op = (float*)out; *(f32x4*)(op + off + bj * 128) = v0; *(f32x4*)(op + off + bj * 128 + 4) = v1; }
                    else { u32x4 w; w.x = cvt_pk_bf16(v0[0], v0[1]); w.y = cvt_pk_bf16(v0[2], v0[3]); w.z = cvt_pk_bf16(v1[0], v1[1]); w.w = cvt_pk_bf16(v1[2], v1[3]);
                        *(u32x4*)((bf16_t*)out + off + bj * 128) = w; } }
                sq += __shfl_xor(sq, 16); sq += __shfl_xor(sq, 32);
                if (fq == 0) red[(ai * 128 + wr * 64 + m * 16 + fr) * 4 + wc] = sq; }
            asm volatile("" ::: "memory"); }
        asm volatile("s_waitcnt lgkmcnt(0)" ::: "memory"); __builtin_amdgcn_s_barrier(); asm volatile("" ::: "memory");
        { const int t = (wr * 4 + wc) * 64 + fq * 16 + fr; if (t < 256) { const f32x4 p = *(const LAS f32x4*)(red + t * 4); ss[(size_t)(u.pm * 256 + t) * 8 + u.pn] = (p.x + p.y) + (p.z + p.w); } }
    }
};

struct EpiFinal {
    static constexpr bool PERM = true;
    const bf16_t* base; float* out; float* ssp; const float* gain; LAS float* red; XcdBarrier xb; bool xlocal;
    __device__ __forceinline__ void operator()(AccT& acc, const Unit& u, int wr, int wc, int fr, int fq) const {
        const int row0 = u.pm * 256 + wr * 64 + fr, col0 = u.pn * 256 + wc * 32 + 8 * fq;
#pragma unroll
        for (int ai = 0; ai < 2; ++ai) {
            u32x4 raw[4][2];
#pragma unroll
            for (int m = 0; m < 4; ++m)
#pragma unroll
                for (int bj = 0; bj < 2; ++bj) raw[m][bj] = *(const u32x4*)(base + (size_t)(row0 + ai * 128 + m * 16) * D + col0 + bj * 128);
#pragma unroll
            for (int m = 0; m < 4; ++m) { float sq = 0.f;
#pragma unroll
                for (int bj = 0; bj < 2; ++bj) { const u32x4 r = raw[m][bj];
                    const f32x4 v0 = (f32x4){bf_lo(r.x), bf_hi(r.x), bf_lo(r.y), bf_hi(r.y)} + acc[ai][bj][m][0], v1 = (f32x4){bf_lo(r.z), bf_hi(r.z), bf_lo(r.w), bf_hi(r.w)} + acc[ai][bj][m][1];
                    acc[ai][bj][m][0] = v0; acc[ai][bj][m][1] = v1;
                    sq += (v0[0] * v0[0] + v0[1] * v0[1]) + (v0[2] * v0[2] + v0[3] * v0[3]) + (v1[0] * v1[0] + v1[1] * v1[1]) + (v1[2] * v1[2] + v1[3] * v1[3]); }
                sq += __shfl_xor(sq, 16); sq += __shfl_xor(sq, 32);
                if (fq == 0) red[(ai * 128 + wr * 64 + m * 16 + fr) * 4 + wc] = sq; }
        }
        asm volatile("s_waitcnt lgkmcnt(0)" ::: "memory"); __builtin_amdgcn_s_barrier(); asm volatile("" ::: "memory");
        { const int t = (wr * 4 + wc) * 64 + fq * 16 + fr; if (t < 256) { const f32x4 p = *(const LAS f32x4*)(red + t * 4); ssp[(size_t)(u.pm * 256 + t) * 8 + u.pn] = (p.x + p.y) + (p.z + p.w); } }
        if (xlocal) xcd_local_barrier(xb); else xcd_barrier(xb);
        f32x4 gv[2][2];
#pragma unroll
        for (int bj = 0; bj < 2; ++bj) { gv[bj][0] = *(const f32x4*)(gain + col0 + bj * 128); gv[bj][1] = *(const f32x4*)(gain + col0 + bj * 128 + 4); }
        float rs[8]; rstd8(rs, ssp, row0);
#pragma unroll
        for (int ai = 0; ai < 2; ++ai)
#pragma unroll
            for (int m = 0; m < 4; ++m) { const int row = row0 + ai * 128 + m * 16; const float rstd = rs[ai * 4 + m];
#pragma unroll
                for (int bj = 0; bj < 2; ++bj) { float* op = out + (size_t)row * D + col0 + bj * 128;
                    *(f32x4*)op = acc[ai][bj][m][0] * rstd * gv[bj][0]; *(f32x4*)(op + 4) = acc[ai][bj][m][1] * rstd * gv[bj][1]; } }
    }
};

struct EpiRelu2 {
    static constexpr bool PERM = true;
    bf16_t* U; const float* ss; int stage; LAS float* rl;
    __device__ __forceinline__ void operator()(const AccT& acc, const Unit& u, int wr, int wc, int fr, int fq) const {
        const int row0 = u.pm * 256 + wr * 64 + fr, col0 = u.pn * 256 + wc * 32 + 8 * fq;
        float rs[8]; rstd8_cached(rs, ss, (stage << 8) | u.pm, u.pm, rl, wr, wc, fr, fq);
#pragma unroll
        for (int ai = 0; ai < 2; ++ai)
#pragma unroll
            for (int m = 0; m < 4; ++m) { bf16_t* rowp = U + (size_t)(row0 + ai * 128 + m * 16) * FF + col0;
                const float rstd = rs[ai * 4 + m];
#pragma unroll
                for (int bj = 0; bj < 2; ++bj) { f32x4 v0 = acc[ai][bj][m][0], v1 = acc[ai][bj][m][1];
#pragma unroll
                    for (int j = 0; j < 4; ++j) { const float a = fmaxf(v0[j], 0.f) * rstd, b = fmaxf(v1[j], 0.f) * rstd; v0[j] = a * a; v1[j] = b * b; }
                    u32x4 w; w.x = cvt_pk_bf16(v0[0], v0[1]); w.y = cvt_pk_bf16(v0[2], v0[3]); w.z = cvt_pk_bf16(v1[0], v1[1]); w.w = cvt_pk_bf16(v1[2], v1[3]);
                    *(u32x4*)(rowp + bj * 128) = w; } }
    }
};

struct TItem { const float* src; bf16_t* dst; const float* gs; int N, K; };
constexpr int I_IN = (D / 64) * (NIN / 32), I_G = 2 * 8 * (256 / 64) * (256 / 32), I_P = (D / 64) * (D / 32), I_1 = (D / 64) * (FF / 32), I_2 = (FF / 64) * (D / 32);
constexpr int PER_LAYER = I_IN + I_G + 3 * I_P + I_1 + I_2;

struct Args { const float* in[19]; float* out; unsigned char* ws; };
typedef __attribute__((address_space(4))) Args KArgs;

__device__ __forceinline__ void rms_phase(const float* x, const float* g, bf16_t* out, int gw, int NGW, int lane) {
    for (int m = gw; m < M; m += NGW) {
        const f32x4* xr = (const f32x4*)(x + (size_t)m * D) + lane;
        f32x4 v[8]; float s = 0.f;
#pragma unroll
        for (int j = 0; j < 8; ++j) { v[j] = xr[64 * j]; s += (v[j].x * v[j].x + v[j].y * v[j].y) + (v[j].z * v[j].z + v[j].w * v[j].w); }
        const float rstd = rsqrtf(wave_sum(s) * (1.f / D) + EPS);
        u32x2* o = (u32x2*)(out + (size_t)m * D) + lane;
#pragma unroll
        for (int j = 0; j < 8; ++j) { const f32x4 gv = ((const f32x4*)g)[lane + 64 * j]; const f32x4 y = v[j] * rstd * gv; u32x2 w; w.x = cvt_pk_bf16(y.x, y.y); w.y = cvt_pk_bf16(y.z, y.w); o[64 * j] = w; }
    }
}
#define UNPK8(dst, p) do { dst[0] = bf_lo(p.x); dst[1] = bf_hi(p.x); dst[2] = bf_lo(p.y); dst[3] = bf_hi(p.y); dst[4] = bf_lo(p.z); dst[5] = bf_hi(p.z); dst[6] = bf_lo(p.w); dst[7] = bf_hi(p.w); } while (0)
#define UNPKMUL8(dst, p, q) do { dst[0] = bf_lo(p.x) * bf_lo(q.x); dst[1] = bf_hi(p.x) * bf_hi(q.x); dst[2] = bf_lo(p.y) * bf_lo(q.y); dst[3] = bf_hi(p.y) * bf_hi(q.y); \
    dst[4] = bf_lo(p.z) * bf_lo(q.z); dst[5] = bf_hi(p.z) * bf_hi(q.z); dst[6] = bf_lo(p.w) * bf_lo(q.w); dst[7] = bf_hi(p.w) * bf_hi(q.w); } while (0)
#define LD8F(dst, ptr) do { const f32x4 _p = *(const f32x4*)(ptr), _q = *(const f32x4*)((ptr) + 4); dst[0] = _p.x; dst[1] = _p.y; dst[2] = _p.z; dst[3] = _p.w; dst[4] = _q.x; dst[5] = _q.y; dst[6] = _q.z; dst[7] = _q.w; } while (0)

__global__ void __launch_bounds__(512, 2) fwd_megakernel(Args a_unused) {
    extern __shared__ __attribute__((aligned(16))) unsigned char lds_raw[];
    cg::grid_group grid = cg::this_grid();
    LAS unsigned char* lds = (LAS unsigned char*)lds_raw;
    const int G = gridDim.x, NGW = G * 8, NGT = G * 512;
    const int wave_s = __builtin_amdgcn_readfirstlane((int)(threadIdx.x >> 6));
#define MY_TID() (wave_s * 64 + lane_id())
    volatile LAS unsigned* bst = (volatile LAS unsigned*)(lds + 131072 + 64);
    if (MY_TID() < 4) bst[MY_TID()] = 0u;
    if (MY_TID() == 0) ((volatile LAS int*)(lds + 131072 + 8192))[0] = -1;
    __syncthreads();
    XcdBarrier xbar;
    { KArgs* ap0 = (KArgs*)__builtin_amdgcn_kernarg_segment_ptr(); xbar = xcd_barrier_post((unsigned*)ap0->ws, bst); xbar.wave = wave_s; if (MY_TID() == 0) (void)xb_add(&xbar.bar[XB_XCNT(xbar.x)], 1u); }
    if (MY_TID() == 0) { unsigned* ctl = (unsigned*)((KArgs*)__builtin_amdgcn_kernarg_segment_ptr())->ws; bst[2] = xb_add(&ctl[3584 + 64 * xbar.x], 1u); }
#define LOCAL_BAR() do { if (xlocal) xcd_local_barrier(xbar); else xcd_barrier(xbar); } while (0)
#define GRID_BAR() do { for (int _r = 0; _r < REP_BAR; ++_r) xcd_barrier(xbar); } while (0)
#define PHASE_IDS() int tid = MY_TID(); asm volatile("" : "+v"(tid)); const int lane = tid & 63, wave = __builtin_amdgcn_readfirstlane(tid >> 6); const int gw = blockIdx.x * 8 + wave, gt = blockIdx.x * 512 + tid; (void)lane; (void)gw; (void)gt; (void)wave
#define PHASE_IDS_V() int tid = MY_TID(); asm volatile("" : "+v"(tid)); const int lane = tid & 63, wave = __builtin_amdgcn_readfirstlane(tid >> 6); const int gt = vb * 512 + tid; (void)lane; (void)wave
#define ARGS() KArgs* ap = (KArgs*)__builtin_amdgcn_kernarg_segment_ptr(); asm volatile("" : "+s"(ap)); unsigned char* ws = ap->ws; (void)ws

    {
        PHASE_IDS(); ARGS();
#define DECODE_ITEM(T, itv) do { const int _it = (itv); const int l = _it / PER_LAYER; int r = _it % PER_LAYER; unsigned char* wl = ws + WS_W + (size_t)l * LW; \
            const float* W; bf16_t* WT; const float* gs_ = nullptr; int K_, N_, k0, n0, drow0; \
            if (r < I_IN) { gs_ = ap->in[1] + (size_t)l * D; W = ap->in[2] + (size_t)l * D * NIN; WT = (bf16_t*)(wl + OW_IN); K_ = D; N_ = NIN; k0 = 64 * (r / (NIN / 32)); n0 = 32 * (r % (NIN / 32)); { const int sec_ = n0 >> 11, c0_ = n0 & 2047; drow0 = (sec_ == 3 || sec_ == 4) ? 256 * (24 + (c0_ >> 7)) + (c0_ & 127) + (sec_ == 4 ? 128 : 0) : ((sec_ >= 5) ? 256 * (40 + (c0_ >> 7)) + (c0_ & 127) + (sec_ == 6 ? 128 : 0) : n0); } } \
            else if ((r -= I_IN) < I_G) { const int which = r / 256, nb = (r / 32) & 7, kb = (r & 31) / 8, nblk = r & 7; \
                W = (which ? ap->in[8] : ap->in[6]) + (size_t)l * 8 * 256 * 256 + (size_t)nb * 256 * 256; WT = (bf16_t*)(wl + OW_G); K_ = 256; N_ = 256; k0 = 64 * kb; n0 = 32 * nblk; \
                const int c0 = nb * 256 + nblk * 32; drow0 = 256 * (c0 >> 7) + (c0 & 127) + (which ? 128 : 0); } \
            else if ((r -= I_G) < 3 * I_P) { const int w3 = r / I_P; r -= w3 * I_P; W = (w3 == 0 ? ap->in[12] : (w3 == 1 ? ap->in[13] : ap->in[14])) + (size_t)l * D * D; \
                WT = (bf16_t*)(wl + (w3 == 0 ? OW_PA : (w3 == 1 ? OW_PB : OW_O))); K_ = D; N_ = D; k0 = 64 * (r / (D / 32)); n0 = 32 * (r % (D / 32)); drow0 = n0; } \
            else if ((r -= 3 * I_P) < I_1) { gs_ = ap->in[15] + (size_t)l * D; W = ap->in[16] + (size_t)l * D * FF; WT = (bf16_t*)(wl + OW_1); K_ = D; N_ = FF; k0 = 64 * (r / (FF / 32)); n0 = 32 * (r % (FF / 32)); drow0 = n0; } \
            else { r -= I_1; W = ap->in[17] + (size_t)l * FF * D; WT = (bf16_t*)(wl + OW_2); K_ = FF; N_ = D; k0 = 64 * (r / (D / 32)); n0 = 32 * (r % (D / 32)); drow0 = n0; } \
            const int kg = lane >> 3, nl = lane & 7; \
            T.src = W + (size_t)(k0 + 8 * kg) * N_ + n0 + 4 * nl; T.dst = WT + (size_t)(drow0 + 4 * nl) * K_ + k0 + 8 * kg; T.gs = gs_ ? gs_ + k0 + 8 * kg : nullptr; T.N = N_; T.K = K_; } while (0)
#define STORE_ITEM(T, v) do { _Pragma("unroll") for (int j = 0; j < 4; ++j) { u32x4 o; o.x = cvt_pk_bf16(v[0][j], v[1][j]); o.y = cvt_pk_bf16(v[2][j], v[3][j]); o.z = cvt_pk_bf16(v[4][j], v[5][j]); o.w = cvt_pk_bf16(v[6][j], v[7][j]); \
            *(u32x4*)(T.dst + (size_t)j * T.K) = o; } } while (0)
        for (int rep = 0; rep < REP_P0; ++rep)
        for (int it = gw; it < DEPTH * PER_LAYER; it += 2 * NGW) {
            const bool has1 = (it + NGW) < DEPTH * PER_LAYER;
            TItem t0, t1; DECODE_ITEM(t0, it); DECODE_ITEM(t1, has1 ? it + NGW : it);
            f32x4 v0[8], v1[8];
#pragma unroll
            for (int i = 0; i < 8; ++i) v0[i] = __builtin_nontemporal_load((const f32x4*)(t0.src + (size_t)i * t0.N));
#pragma unroll
            for (int i = 0; i < 8; ++i) v1[i] = __builtin_nontemporal_load((const f32x4*)(t1.src + (size_t)i * t1.N));
            if (t0.gs) { float gq[8]; LD8F(gq, t0.gs);
#pragma unroll
                for (int i = 0; i < 8; ++i) v0[i] *= gq[i]; }
            if (t1.gs) { float gq[8]; LD8F(gq, t1.gs);
#pragma unroll
                for (int i = 0; i < 8; ++i) v1[i] *= gq[i]; }
            STORE_ITEM(t0, v0);
            if (has1) STORE_ITEM(t1, v1);
        }
        {
            const float* x = ap->in[0]; bf16_t* xb = (bf16_t*)(ws + WS_H); float* ss0 = (float*)(ws + WS_SSP);
            for (int m = gw; m < M; m += NGW) {
                const f32x4* xr = (const f32x4*)(x + (size_t)m * D) + lane;
                f32x4 v[8]; float sq = 0.f;
#pragma unroll
                for (int j = 0; j < 8; ++j) { v[j] = xr[64 * j]; sq += (v[j].x * v[j].x + v[j].y * v[j].y) + (v[j].z * v[j].z + v[j].w * v[j].w); }
                sq = wave_sum(sq);
                u32x2* o = (u32x2*)(xb + (size_t)m * D) + lane;
#pragma unroll
                for (int j = 0; j < 8; ++j) { u32x2 w; w.x = cvt_pk_bf16(v[j].x, v[j].y); w.y = cvt_pk_bf16(v[j].z, v[j].w); o[64 * j] = w; }
                if (lane < 8) ss0[(size_t)m * 8 + lane] = lane == 0 ? sq : 0.f;
            }
        }
        if (gt < DEPTH * D) { const float lv = ap->in[10][gt]; ((float*)(ws + WS_C8))[gt] = -8.0f * LOG2E * log1pf(__expf(-lv)); }
    }
    grid.sync();

    int vcu; bool xlocal;
    {
        unsigned* ctl = (unsigned*)((KArgs*)__builtin_amdgcn_kernarg_segment_ptr())->ws;
        bool even = (G % 8) == 0;
#pragma unroll
        for (int j = 0; j < 8; ++j) even = even && (xb_ld(&ctl[3584 + 64 * j]) == (unsigned)(G / 8));
        vcu = even ? (int)(bst[2] * 8u + xbar.x) : (int)blockIdx.x;
        vcu = __builtin_amdgcn_readfirstlane(vcu);
        xlocal = even;
    }
    const int vb = xlocal ? (vcu & 7) * (G >> 3) + (vcu >> 3) : (int)blockIdx.x;
#pragma unroll 1
    for (int l = 0; l < DEPTH; ++l) {
        {
            ARGS();
            pg8::Gemm g{(l == 0) ? (const bf16_t*)(ws + WS_H) : (const bf16_t*)ap->out + SEC, (const bf16_t*)(ws + WS_W + (size_t)l * LW + OW_IN), D, D, 0, 0, nullptr, nullptr}; pg8::StaticOrder S; S.init(M, NIN, G, vcu);
            EpiIn E{(bf16_t*)(ws + WS_Z), ap->in[3] + (size_t)l * NIN, (const float*)(ws + WS_SSP) + (size_t)(2 * l) * M * 8, 2 * l + 1, (LAS float*)(lds + 131072 + 8192)};
            for (int rep = 0; rep < REP_G1; ++rep) pg8::gemm_phase<EpiIn>(lds, g, S, E, wave_s);
        }
        GRID_BAR();
        {
            PHASE_IDS_V(); ARGS();
            bf16_t* Z = (bf16_t*)(ws + WS_Z); bf16_t* Hb = (bf16_t*)(ws + WS_H);
            const bf16_t* Zxa = Z; bf16_t* Zcb = Z + 2 * SEC; const bf16_t* Zp = Z + 3 * SEC;
            const float* caw = ap->in[4] + (size_t)l * 4 * D; const float* cab = ap->in[5] + (size_t)l * D; const float* cbw = ap->in[11] + (size_t)l * 3 * D;
            for (int item = gt; item < (M / 32) * (D / 8); item += NGT) {
                const int grp = item & 255, run = item >> 8, t0 = run * 32, c0 = grp * 8;
                const bool first = (t0 % SEQ) == 0;
                {
                    float w0[8], w1[8], w2[8], w3[8], bia[8];
                    LD8F(w0, caw + c0); LD8F(w1, caw + D + c0); LD8F(w2, caw + 2 * D + c0); LD8F(w3, caw + 3 * D + c0); LD8F(bia, cab + c0);
                    float x0[8], x1[8], x2[8];
#pragma unroll
                    for (int j = 0; j < 8; ++j) { x0[j] = 0.f; x1[j] = 0.f; x2[j] = 0.f; }
                    if (!first) {
                        const u32x4 p0 = *(const u32x4*)(Zxa + (size_t)(t0 - 3) * D + c0), p1 = *(const u32x4*)(Zxa + (size_t)(t0 - 2) * D + c0), p2 = *(const u32x4*)(Zxa + (size_t)(t0 - 1) * D + c0);
                        UNPK8(x0, p0); UNPK8(x1, p1); UNPK8(x2, p2);
                    }
                    float sx0[8], sx1[8], sx2[8];
#pragma unroll
                    for (int j = 0; j < 8; ++j) { sx0[j] = x0[j]; sx1[j] = x1[j]; sx2[j] = x2[j]; }
#pragma unroll 1
                    for (int tbr = 0; tbr < 32 * REP_CA; tbr += 8) { const int tb = tbr & 31;
                        if (tb == 0 && tbr != 0) {
#pragma unroll
                            for (int j = 0; j < 8; ++j) { x0[j] = sx0[j]; x1[j] = sx1[j]; x2[j] = sx2[j]; } }
                        u32x4 pv[8];
#pragma unroll
                        for (int t = 0; t < 8; ++t) pv[t] = __builtin_nontemporal_load((const u32x4*)(Zxa + (size_t)(t0 + tb + t) * D + c0));
#pragma unroll
                        for (int t = 0; t < 8; ++t) {
                            float xc[8]; UNPK8(xc, pv[t]);
                            float y[8];
#pragma unroll
                            for (int j = 0; j < 8; ++j) { y[j] = bia[j] + w0[j] * x0[j] + w1[j] * x1[j] + w2[j] * x2[j] + w3[j] * xc[j]; x0[j] = x1[j]; x1[j] = x2[j]; x2[j] = xc[j]; }
                            u32x4 o; o.x = cvt_pk_bf16(y[0], y[1]); o.y = cvt_pk_bf16(y[2], y[3]); o.z = cvt_pk_bf16(y[4], y[5]); o.w = cvt_pk_bf16(y[6], y[7]);
                            *(u32x4*)(Hb + (size_t)(t0 + tb + t) * D + c0) = o;
                        }
                    }
                }
                {
                    float w0[8], w1[8], w2[8];
                    LD8F(w0, cbw + c0); LD8F(w1, cbw + D + c0); LD8F(w2, cbw + 2 * D + c0);
                    float x1[8], x2[8];
#pragma unroll
                    for (int j = 0; j < 8; ++j) { x1[j] = 0.f; x2[j] = 0.f; }
                    if (!first) {
                        const u32x4 p1 = *(const u32x4*)(Zp + (size_t)(t0 - 2) * D + c0), p2 = *(const u32x4*)(Zp + (size_t)(t0 - 1) * D + c0);
                        UNPK8(x1, p1); UNPK8(x2, p2);
                    }
#pragma unroll 1
                    for (int tb = 0; tb < 32; tb += 8) {
                        u32x4 pv[8], bv[8];
#pragma unroll
                        for (int t = 0; t < 8; ++t) { const size_t off = (size_t)(t0 + tb + t) * D + c0; pv[t] = __builtin_nontemporal_load((const u32x4*)(Zp + off)); bv[t] = __builtin_nontemporal_load((const u32x4*)(Zcb + off)); }
#pragma unroll
                        for (int t = 0; t < 8; ++t) {
                            float xc[8]; UNPK8(xc, pv[t]);
                            float cbv[8]; UNPK8(cbv, bv[t]);
                            float y[8];
#pragma unroll
                            for (int j = 0; j < 8; ++j) { y[j] = cbv[j] * (w0[j] * x1[j] + w1[j] * x2[j] + w2[j] * xc[j]); x1[j] = x2[j]; x2[j] = xc[j]; }
                            u32x4 o; o.x = cvt_pk_bf16(y[0], y[1]); o.y = cvt_pk_bf16(y[2], y[3]); o.z = cvt_pk_bf16(y[4], y[5]); o.w = cvt_pk_bf16(y[6], y[7]);
                            *(u32x4*)(Zcb + (size_t)(t0 + tb + t) * D + c0) = o;
                        }
                    }
                }
            }
        }
        LOCAL_BAR();
        {
            ARGS();
            pg8::Gemm g{(const bf16_t*)(ws + WS_H), (const bf16_t*)(ws + WS_W + (size_t)l * LW + OW_G), D, 256, 1, 256, nullptr, nullptr}; pg8::StaticOrder S; S.init(M, 2 * D, G, vcu);
            EpiGate E{(const bf16_t*)(ws + WS_H), (bf16_t*)(ws + WS_Z) + 4 * SEC, (bf16_t*)(ws + WS_B), ap->in[7] + (size_t)l * D, ap->in[9] + (size_t)l * D, (const float*)(ws + WS_C8) + (size_t)l * D};
            for (int rep = 0; rep < REP_G2; ++rep) pg8::gemm_phase<EpiGate>(lds, g, S, E, wave_s);
        }
        LOCAL_BAR();
        {
            PHASE_IDS_V(); ARGS();
            const bf16_t* Zxa = (const bf16_t*)(ws + WS_Z) + 4 * SEC; const bf16_t* Bb = (const bf16_t*)(ws + WS_B); float* AggA = (float*)(ws + WS_AGG); float* AggB = AggA + 256 * D;
            for (int rep = 0; rep < REP_S1; ++rep)
            for (int item = gt; item < (M / 64) * (D / 4); item += NGT) {
                const int grp = item & 511, chunk = item >> 9, t0 = chunk * 64, c0 = grp * 4;
                f32x4 h = {0.f, 0.f, 0.f, 0.f}, P = {0.f, 0.f, 0.f, 0.f};
#pragma unroll 8
                for (int t = 0; t < 64; ++t) {
                    const size_t off = (size_t)(t0 + t) * D + c0;
                    const u32x2 lw = *(const u32x2*)(Zxa + off), bw = *(const u32x2*)(Bb + off);
                    const f32x4 la = {bf_lo(lw.x), bf_hi(lw.x), bf_lo(lw.y), bf_hi(lw.y)}, bv = {bf_lo(bw.x), bf_hi(bw.x), bf_lo(bw.y), bf_hi(bw.y)};
                    f32x4 av; av.x = __builtin_amdgcn_exp2f(la.x); av.y = __builtin_amdgcn_exp2f(la.y); av.z = __builtin_amdgcn_exp2f(la.z); av.w = __builtin_amdgcn_exp2f(la.w);
                    h = av * h + bv; P += la;
                }
                f32x4 Av; Av.x = __builtin_amdgcn_exp2f(P.x); Av.y = __builtin_amdgcn_exp2f(P.y); Av.z = __builtin_amdgcn_exp2f(P.z); Av.w = __builtin_amdgcn_exp2f(P.w);
                *(f32x4*)(AggA + (size_t)chunk * D + c0) = Av; *(f32x4*)(AggB + (size_t)chunk * D + c0) = h;
            }
        }
        GRID_BAR();
        {
            PHASE_IDS_V(); ARGS();
            const bf16_t* Zxa = (const bf16_t*)(ws + WS_Z) + 4 * SEC; const bf16_t* Bb = (const bf16_t*)(ws + WS_B); const float* AggA = (const float*)(ws + WS_AGG); const float* AggB = AggA + 256 * D;
            const bf16_t* Zgy = (const bf16_t*)(ws + WS_Z) + SEC; bf16_t* Zhy = (bf16_t*)(ws + WS_Z) + 3 * SEC;
            for (int rep = 0; rep < REP_S3; ++rep)
            for (int item = gt; item < (M / 64) * (D / 4); item += NGT) {
                const int grp = item & 511, chunk = item >> 9, t0 = chunk * 64, c0 = grp * 4;
                const int cfirst = chunk & ~63;
                f32x4 h = {0.f, 0.f, 0.f, 0.f};
#pragma unroll 1
                for (int cb8 = cfirst; cb8 < chunk; cb8 += 8) {
                    f32x4 Av[8], Bv[8];
#pragma unroll
                    for (int k = 0; k < 8; ++k) { Av[k] = *(const f32x4*)(AggA + (size_t)(cb8 + k) * D + c0); Bv[k] = *(const f32x4*)(AggB + (size_t)(cb8 + k) * D + c0); }
#pragma unroll
                    for (int k = 0; k < 8; ++k) { const bool use = (cb8 + k) < chunk; const f32x4 hn = Av[k] * h + Bv[k]; h = use ? hn : h; }
                }
#pragma unroll 1
                for (int tb = 0; tb < 64; tb += 8) {
                    u32x2 lw[8], bw[8], gv[8];
#pragma unroll
                    for (int t = 0; t < 8; ++t) { const size_t off = (size_t)(t0 + tb + t) * D + c0; lw[t] = __builtin_nontemporal_load((const u32x2*)(Zxa + off)); bw[t] = __builtin_nontemporal_load((const u32x2*)(Bb + off)); gv[t] = __builtin_nontemporal_load((const u32x2*)(Zgy + off)); }
#pragma unroll
                    for (int t = 0; t < 8; ++t) {
                        const f32x4 la = {bf_lo(lw[t].x), bf_hi(lw[t].x), bf_lo(lw[t].y), bf_hi(lw[t].y)}, bv = {bf_lo(bw[t].x), bf_hi(bw[t].x), bf_lo(bw[t].y), bf_hi(bw[t].y)};
                        const f32x4 gy = {gelu_tanh(bf_lo(gv[t].x)), gelu_tanh(bf_hi(gv[t].x)), gelu_tanh(bf_lo(gv[t].y)), gelu_tanh(bf_hi(gv[t].y))};
                        f32x4 av; av.x = __builtin_amdgcn_exp2f(la.x); av.y = __builtin_amdgcn_exp2f(la.y); av.z = __builtin_amdgcn_exp2f(la.z); av.w = __builtin_amdgcn_exp2f(la.w);
                        h = av * h + bv;
                        const f32x4 y = h * gy;
                        u32x2 o; o.x = cvt_pk_bf16(y.x, y.y); o.y = cvt_pk_bf16(y.z, y.w);
                        *(u32x2*)(Zhy + (size_t)(t0 + tb + t) * D + c0) = o;
                    }
                }
            }
        }
        LOCAL_BAR();
        {
            ARGS();
            bf16_t* Z = (bf16_t*)(ws + WS_Z);
            pg8::StaticOrder S; S.init(M, D, G, vcu);
            pg8::Gemm g{Z + 3 * SEC, (const bf16_t*)(ws + WS_W + (size_t)l * LW + OW_PA), D, D, 0, 0, Z + 2 * SEC, (const bf16_t*)(ws + WS_W + (size_t)l * LW + OW_PB)};
            EpiMerge2 E{Z + 5 * SEC, Z + 6 * SEC};
            pg8::gemm_phase<EpiMerge2, 2>(lds, g, S, E, wave_s);
        }
        LOCAL_BAR();
        {
            ARGS();
            pg8::Gemm g{(const bf16_t*)(ws + WS_Z) + 5 * SEC, (const bf16_t*)(ws + WS_W + (size_t)l * LW + OW_O), D, D, 0, 0, nullptr, nullptr}; pg8::StaticOrder S; S.init(M, D, G, vcu);
            bf16_t* R1 = (l + 1 == DEPTH) ? (bf16_t*)(ws + WS_H) : (bf16_t*)ap->out; bf16_t* R2 = (bf16_t*)ap->out + SEC;
            EpiResid E{(l == 0) ? (const void*)ap->in[0] : (const void*)R2, (void*)R1, (float*)(ws + WS_SSP) + (size_t)(2 * l + 1) * M * 8, l != 0, false, (LAS float*)(lds + 131072 + 1024)};
            pg8::gemm_phase<EpiResid>(lds, g, S, E, wave_s);
        }
        LOCAL_BAR();
        {
            ARGS();
            pg8::Gemm g{(l + 1 == DEPTH) ? (const bf16_t*)(ws + WS_H) : (const bf16_t*)ap->out, (const bf16_t*)(ws + WS_W + (size_t)l * LW + OW_1), D, D, 0, 0, nullptr, nullptr}; pg8::StaticOrder S; S.init(M, FF, G, vcu);
            EpiRelu2 E{(bf16_t*)(ws + WS_Z), (const float*)(ws + WS_SSP) + (size_t)(2 * l + 1) * M * 8, 2 * l + 2, (LAS float*)(lds + 131072 + 8192)};
            for (int rep = 0; rep < REP_G6; ++rep) pg8::gemm_phase<EpiRelu2>(lds, g, S, E, wave_s);
        }
        LOCAL_BAR();
        if (l + 1 < DEPTH) {
            ARGS();
            pg8::Gemm g{(const bf16_t*)(ws + WS_Z), (const bf16_t*)(ws + WS_W + (size_t)l * LW + OW_2), FF, FF, 0, 0, nullptr, nullptr}; pg8::StaticOrder S; S.init(M, D, G, vcu); S.revr = true;
            bf16_t* R1 = (bf16_t*)ap->out; bf16_t* R2 = R1 + SEC;
            EpiResid E{(const void*)R1, (void*)R2, (float*)(ws + WS_SSP) + (size_t)(2 * l + 2) * M * 8, true, false, (LAS float*)(lds + 131072 + 1024)};
            pg8::gemm_phase<EpiResid>(lds, g, S, E, wave_s);
            LOCAL_BAR();
        } else {
            ARGS();
            pg8::Gemm g{(const bf16_t*)(ws + WS_Z), (const bf16_t*)(ws + WS_W + (size_t)l * LW + OW_2), FF, FF, 0, 0, nullptr, nullptr}; pg8::StaticOrder S; S.init(M, D, G, vcu, true); S.revr = true;
            EpiFinal E{(const bf16_t*)(ws + WS_H), ap->out, (float*)(ws + WS_SSP) + (size_t)4 * M * 8, ap->in[18], (LAS float*)(lds + 131072 + 1024), xbar, xlocal};
            pg8::gemm_phase<EpiFinal>(lds, g, S, E, wave_s);
        }
    }
}

extern "C" void kernel_launch(void* const* d_in, const int* in_sizes, int n_in, void* d_out, int out_size, void* d_ws, size_t ws_size, hipStream_t stream) {
    static int grid = 0;
    if (grid == 0) {
        if (n_in != 19 || out_size != M * D || ws_size < WS_END) { fprintf(stderr, "kernel_launch: unexpected shapes n_in %d out %d ws %zu\n", n_in, out_size, ws_size); grid = -1; return; }
        int dev = 0, cus = 0, per_cu = 0;
        hipGetDevice(&dev); hipDeviceGetAttribute(&cus, hipDeviceAttributeMultiprocessorCount, dev);
        if (hipFuncSetAttribute((const void*)fwd_megakernel, hipFuncAttributeMaxDynamicSharedMemorySize, LDS_BYTES) != hipSuccess) { fprintf(stderr, "kernel_launch: hipFuncSetAttribute failed\n"); grid = -1; return; }
        if (hipOccupancyMaxActiveBlocksPerMultiprocessor(&per_cu, (const void*)fwd_megakernel, 512, LDS_BYTES) != hipSuccess || per_cu < 1) { fprintf(stderr, "kernel_launch: occupancy query says %d\n", per_cu); per_cu = 1; }
        (void)hipGetLastError();
        grid = cus * 1;
    }
    if (grid < 0) return;
    if (hipMemsetAsync(d_ws, 0, 65536, stream) != hipSuccess) { fprintf(stderr, "kernel_launch: memset failed\n"); return; }
    Args a{};
    for (int i = 0; i < 19; ++i) a.in[i] = (const float*)d_in[i];
    a.out = (float*)d_out; a.ws = (unsigned char*)d_ws;
    void* args[] = {&a};
    hipError_t e = hipLaunchCooperativeKernel((const void*)fwd_megakernel, dim3(grid), dim3(512), args, LDS_BYTES, stream);
    if (e != hipSuccess) fprintf(stderr, "cooperative launch failed: %s (grid %d)\n", hipGetErrorString(e), grid);
}
```

```cpp
#include <hip/hip_runtime.h>
#include <hip/hip_cooperative_groups.h>
#include <cstdio>
#include <cstdint>
namespace cg = cooperative_groups;

#define LAS __attribute__((address_space(3)))
typedef unsigned short bf16_t;
typedef short bf16x8 __attribute__((ext_vector_type(8)));
typedef float f32x4 __attribute__((ext_vector_type(4)));
typedef float f32x2 __attribute__((ext_vector_type(2)));
typedef unsigned u32x4 __attribute__((ext_vector_type(4)));
typedef unsigned u32x2 __attribute__((ext_vector_type(2)));

constexpr int M = 16384, D = 2048, NIN = 14336, FF = 8192, SEQ = 4096, DEPTH = 2;
constexpr float EPS = 1e-6f;
constexpr float LOG2E = 1.4426950408889634f;

constexpr size_t MiB = 1u << 20;
constexpr size_t WS_SS = 65536;
constexpr size_t WS_C8 = 1 * MiB;
constexpr size_t WS_W = 2 * MiB, LW = 146 * MiB;
constexpr size_t OW_IN = 0, OW_G = 56 * MiB, OW_PA = 58 * MiB, OW_PB = 66 * MiB, OW_O = 74 * MiB, OW_1 = 82 * MiB, OW_2 = 114 * MiB;
constexpr size_t WS_Z = 296 * MiB;
constexpr size_t SEC = (size_t)M * D;
constexpr size_t WS_H = 744 * MiB;
constexpr size_t WS_B = 808 * MiB;
constexpr size_t WS_AGG = 872 * MiB;
constexpr size_t WS_SSP = 876 * MiB;
constexpr size_t WS_END = 880 * MiB;

constexpr int LDS_BYTES = 147456;
constexpr int REP_P0 = 1, REP_R = 1, REP_G1 = 1, REP_G2 = 1, REP_S1 = 1, REP_G6 = 1, REP_BAR = 1, REP_S3 = 1, REP_CA = 1;

__device__ __forceinline__ unsigned cvt_pk_bf16(float lo, float hi) { unsigned r; asm volatile("v_cvt_pk_bf16_f32 %0, %1, %2" : "=v"(r) : "v"(lo), "v"(hi)); return r; }
__device__ __forceinline__ float bf_lo(unsigned w) { return __uint_as_float(w << 16); }
__device__ __forceinline__ float bf_hi(unsigned w) { return __uint_as_float(w & 0xffff0000u); }
__device__ __forceinline__ float fast_sigmoid(float v) { return __builtin_amdgcn_rcpf(1.0f + __builtin_amdgcn_exp2f(-LOG2E * v)); }
__device__ __forceinline__ float gelu_tanh(float v) {
    const float t = v * (1.0f + 0.044715f * v * v);
    return v * __builtin_amdgcn_rcpf(1.0f + __builtin_amdgcn_exp2f(-2.0f * 0.7978845608028654f * LOG2E * t));
}
__device__ __forceinline__ float rstd_of(const float* ssp, int row) {
    const f32x4 a = *(const f32x4*)(ssp + (size_t)row * 8), b = *(const f32x4*)(ssp + (size_t)row * 8 + 4);
    return rsqrtf((((a.x + a.y) + (a.z + a.w)) + ((b.x + b.y) + (b.z + b.w))) * (1.f / D) + EPS);
}
__device__ __forceinline__ void rstd8(float (&r)[8], const float* ssp, int row0) {
#pragma unroll
    for (int h = 0; h < 2; ++h) {
        f32x4 a[4], b[4];
#pragma unroll
        for (int q = 0; q < 4; ++q) { const size_t o = (size_t)(row0 + h * 128 + q * 16) * 8; a[q] = *(const f32x4*)(ssp + o); b[q] = *(const f32x4*)(ssp + o + 4); }
#pragma unroll
        for (int q = 0; q < 4; ++q) r[h * 4 + q] = rsqrtf((((a[q].x + a[q].y) + (a[q].z + a[q].w)) + ((b[q].x + b[q].y) + (b[q].z + b[q].w))) * (1.f / D) + EPS);
    }
}
__device__ __forceinline__ void rstd8_cached(float (&r)[8], const float* ssp, int tag, int pm, LAS float* rl, int wr, int wc, int fr, int fq) {
    const int cur = ((volatile LAS int*)rl)[0];
    if (cur != tag) {
        asm volatile("s_waitcnt lgkmcnt(0)" ::: "memory"); __builtin_amdgcn_s_barrier(); asm volatile("" ::: "memory");
        const int t = (wr * 4 + wc) * 64 + fq * 16 + fr;
        if (t < 256) { const size_t o = (size_t)(pm * 256 + t) * 8; const f32x4 a = *(const f32x4*)(ssp + o), b = *(const f32x4*)(ssp + o + 4);
            rl[64 + t] = rsqrtf((((a.x + a.y) + (a.z + a.w)) + ((b.x + b.y) + (b.z + b.w))) * (1.f / D) + EPS);
            if (t == 0) ((LAS int*)rl)[0] = tag; }
        asm volatile("s_waitcnt lgkmcnt(0)" ::: "memory"); __builtin_amdgcn_s_barrier(); asm volatile("" ::: "memory");
    }
#pragma unroll
    for (int q = 0; q < 8; ++q) r[q] = rl[64 + (q >> 2) * 128 + wr * 64 + (q & 3) * 16 + fr];
}
__device__ __forceinline__ float wave_sum(float v) {
#pragma unroll
    for (int o = 1; o < 64; o <<= 1) v += __shfl_xor(v, o);
    return v;
}
#define LDS_WAIT() asm volatile("s_waitcnt lgkmcnt(0)" ::: "memory")
__device__ __forceinline__ int lane_id() { int l; asm volatile("v_mbcnt_lo_u32_b32 %0, -1, 0\n\tv_mbcnt_hi_u32_b32 %0, -1, %0" : "=v"(l)); return l; }


#define XB_TMO      128
#define XB_XCNT(j)  (256  + 64 * (j))
#define XB_XSUB(j)  (1280 + 64 * (j))
#define XB_XGEN(j)  (2304 + 64 * (j))
#define XB_TOP      3328
#define XB_TOPGEN   3392
#define XCD_BAR_WORDS 3456
#define XB_SPIN_CAP (1u << 22)
__device__ __forceinline__ unsigned xb_ld(unsigned* p)              { return __hip_atomic_load(p, __ATOMIC_RELAXED, __HIP_MEMORY_SCOPE_AGENT); }
__device__ __forceinline__ unsigned xb_add(unsigned* p, unsigned v) { return __hip_atomic_fetch_add(p, v, __ATOMIC_RELAXED, __HIP_MEMORY_SCOPE_AGENT); }
__device__ __forceinline__ unsigned xb_xcc_id() { return (unsigned)__builtin_amdgcn_s_getreg((3 << 11) | 20) & 0xFu; }
#define XB_SPIN(cond, bar) do { unsigned _sp = 0; while (cond) { __builtin_amdgcn_s_sleep(1); \
    if ((++_sp & 255u) == 0u) { if (xb_ld(&(bar)[XB_TMO])) break; if (_sp > XB_SPIN_CAP) { atomicAdd(&(bar)[XB_TMO], 1u); break; } } } } while (0)
struct XcdBarrier { unsigned* bar; unsigned x; volatile LAS unsigned* st; int wave; };
__device__ __forceinline__ XcdBarrier xcd_barrier_post(unsigned* bar, volatile LAS unsigned* st) {
    XcdBarrier b; b.bar = bar; b.x = xb_xcc_id(); b.st = st; b.wave = 0;
    return b;
}
__device__ __forceinline__ void xcd_barrier_complete(unsigned* bar, unsigned x, unsigned& nloc, unsigned& nx) {
    const unsigned G = gridDim.x * gridDim.y * gridDim.z;
    unsigned sum, cnt, mine, sp = 0u;
    for (;;) {
        sum = 0u; cnt = 0u; mine = 0u;
#pragma unroll
        for (unsigned j = 0; j < 16; ++j) { const unsigned c = xb_ld(&bar[XB_XCNT(j)]); sum += c; cnt += (c > 0u) ? 1u : 0u; mine = (j == x) ? c : mine; }
        if (sum == G) break;
        __builtin_amdgcn_s_sleep(1);
        if ((++sp & 255u) == 0u) { if (xb_ld(&bar[XB_TMO])) break; if (sp > XB_SPIN_CAP) { atomicAdd(&bar[XB_TMO], 1u); break; } }
    }
    nloc = mine > 0u ? mine : 1u; nx = cnt > 0u ? cnt : 1u;
}
__device__ __forceinline__ void xcd_barrier(const XcdBarrier& b) {
    asm volatile("s_waitcnt vmcnt(0)" ::: "memory");
    __syncthreads();
    if (b.wave == 0 && lane_id() == 0) {
        unsigned* bar = b.bar;
        __builtin_amdgcn_s_waitcnt(0);
        unsigned nloc = b.st[0], nx = b.st[1];
        if (nloc == 0u) { xcd_barrier_complete(bar, b.x, nloc, nx); b.st[0] = nloc; b.st[1] = nx; }
        const unsigned old = xb_add(&bar[XB_XSUB(b.x)], 1u);
        const unsigned gen = old / nloc;
        if (old + 1u == (gen + 1u) * nloc) {
            __builtin_amdgcn_fence(__ATOMIC_RELEASE, "agent");
            asm volatile("s_waitcnt vmcnt(0)" ::: "memory");
            const unsigned og = xb_add(&bar[XB_TOP], 1u);
            const unsigned tg = og / nx;
            if (og + 1u == (tg + 1u) * nx) xb_add(&bar[XB_TOPGEN], 1u);
            else XB_SPIN(xb_ld(&bar[XB_TOPGEN]) == tg, bar);
            __builtin_amdgcn_fence(__ATOMIC_ACQUIRE, "agent");
            xb_add(&bar[XB_XGEN(b.x)], 1u);
            asm volatile("s_waitcnt vmcnt(0)" ::: "memory");
        } else {
            XB_SPIN(xb_ld(&bar[XB_XGEN(b.x)]) == gen, bar);
            __builtin_amdgcn_fence(__ATOMIC_ACQUIRE, "agent");
            asm volatile("s_waitcnt vmcnt(0)" ::: "memory");
        }
    }
    __syncthreads();
}

#define XB_LSUB(j)  (4096 + 64 * (j))
#define XB_LGEN(j)  (5120 + 64 * (j))
__device__ __forceinline__ void xcd_local_barrier(const XcdBarrier& b) {
    asm volatile("s_waitcnt vmcnt(0)" ::: "memory");
    __syncthreads();
    if (b.wave == 0 && lane_id() == 0) {
        unsigned* bar = b.bar;
        __builtin_amdgcn_s_waitcnt(0);
        const unsigned nloc = b.st[0];
        const unsigned old = xb_add(&bar[XB_LSUB(b.x)], 1u);
        const unsigned gen = old / nloc;
        if (old + 1u == (gen + 1u) * nloc) xb_add(&bar[XB_LGEN(b.x)], 1u);
        else XB_SPIN(xb_ld(&bar[XB_LGEN(b.x)]) == gen, bar);
        __builtin_amdgcn_fence(__ATOMIC_ACQUIRE, "agent");
        asm volatile("s_waitcnt vmcnt(0)" ::: "memory");
    }
    __syncthreads();
}

namespace pg8 {
constexpr int BM = 256, BK = 64, HALF = 128, HTB = HALF * BK * 2, STAGE_BYTES = 8 * HTB, NXCD = 8, WGM = 4;
__host__ __device__ __forceinline__ int lds_byte(int r, int c) { const int st = (r >> 4) * 2 + (c >> 5), rr = r & 15, cc = c & 31, ob = rr * 64 + cc * 2; return st * 1024 + (ob ^ (((ob >> 9) & 1) << 5)); }
__host__ __device__ __forceinline__ void stage_rc(int b, int& R, int& C) { const int st = b / 1024, sb = b % 1024, swz = sb ^ (((sb >> 9) & 1) << 5); R = (st >> 1) * 16 + swz / 64; C = (st & 1) * 32 + (swz % 64) / 2; }
__host__ __device__ __forceinline__ int perm32(int rho) { const int n = rho >> 4, i = rho & 15; return 8 * (i >> 2) + 4 * n + (i & 3); }

struct Unit { int pm, pn; };
struct Gemm { const bf16_t* A; const bf16_t* Bt; int lda, K, ash, amul; const bf16_t* A2; const bf16_t* Bt2; };

struct StaticOrder {
    int nM, nN, nwg, G, c, gsel; bool revr; bool pmajor;
    __device__ void init(int M_, int N_, int G_, int c_, bool pmajor_ = false) { nM = M_ / BM; nN = N_ / BM; nwg = nM * nN; G = G_; c = c_; pmajor = pmajor_; revr = false; gsel = -1; }
    __device__ bool next(int i, Unit& u) const {
        int wgid;
        if (gsel >= 0) {
            const int nigs = WGM * nN, off = i * (G / NXCD) + c / NXCD;
            if (off >= nigs) return false;
            wgid = (c % NXCD) * (nwg / NXCD) + gsel * nigs + off;
        } else {
        if ((long)i * G + c >= nwg) return false;
        const int nR = nwg / G; const int ii = (revr && nwg % G == 0) ? (nR - 1 - i) : i;
        const long L = (long)ii * G + c;
        wgid = (int)L; { const int q = nwg / NXCD, r = nwg % NXCD, xcd = wgid % NXCD, off = wgid / NXCD; wgid = (xcd < r ? xcd * (q + 1) : r * (q + 1) + (xcd - r) * q) + off; }
        }
        const int nig = WGM * nN, gid = wgid / nig, fm = gid * WGM, gsz = (nM - fm) < WGM ? (nM - fm) : WGM;
        const int w = wgid % nig;
        if (pmajor) { u.pn = w % nN; u.pm = fm + w / nN; } else { u.pm = fm + (w % gsz); u.pn = w / gsz; }
        return true;
    }
};

template <class Epi, int NSEG = 1>
__device__ __forceinline__ void gemm_phase(LAS unsigned char* lds, const Gemm g, const StaticOrder& S, const Epi& E, int wave_s) {
    int tid = wave_s * 64 + lane_id(); asm volatile("" : "+v"(tid));
    const int wid = __builtin_amdgcn_readfirstlane(tid >> 6), lane = tid & 63, wr = wid >> 2, wc = wid & 3, fr = lane & 15, fq = lane >> 4;
    const int K = g.K, nt = K / BK, lda = g.lda;
    unsigned voffA[2], voffB[2];
#pragma unroll
    for (int i = 0; i < 2; ++i) { int R, C; stage_rc(tid * 16 + i * 8192, R, C); const int Rb = Epi::PERM ? ((R & ~31) + perm32(R & 31)) : R;
        voffA[i] = (unsigned)(R * lda + C) * 2u; voffB[i] = (unsigned)(Rb * K + C) * 2u; }
    const size_t kstep = (size_t)(BK * 2);
    const size_t hstepA = (size_t)HALF * lda * 2, hstepB = (size_t)HALF * K * 2;
    const size_t tstepA = 2 * hstepA, tstepB = 2 * hstepB;
    const unsigned ldsw = (unsigned)wid * 1024u;
    const int aoff = lds_byte(wr * 64 + fr, fq * 8), boff = lds_byte(wc * 32 + fr, fq * 8);
#define PG8_SA(b, h) (((b) * 2 + (h)) * HTB)
#define PG8_SB(b, h) ((4 + (b) * 2 + (h)) * HTB)
#define PG8_STAGE(bufoff, gbase, voff) do { _Pragma("unroll") for (int _i = 0; _i < 2; ++_i) \
        __builtin_amdgcn_global_load_lds((const unsigned*)((const char*)(gbase) + (voff)[_i]), (LAS unsigned*)(lds + (bufoff) + ldsw + _i * 8192), 16, 0, 0); } while (0)
#define PG8_LDA(dst, b, h) do { _Pragma("unroll") for (int m = 0; m < 4; ++m) _Pragma("unroll") for (int k = 0; k < 2; ++k) dst[m][k] = *(const LAS bf16x8*)(lds + PG8_SA(b, h) + aoff + m * 2048 + k * 1024); } while (0)
#define PG8_LDB(dst, b, h) do { _Pragma("unroll") for (int n = 0; n < 2; ++n) _Pragma("unroll") for (int k = 0; k < 2; ++k) dst[n][k] = *(const LAS bf16x8*)(lds + PG8_SB(b, h) + boff + n * 2048 + k * 1024); } while (0)
#define PG8_MMA(ai, bj, At, Bt) do { __builtin_amdgcn_s_setprio(1); _Pragma("unroll") for (int m = 0; m < 4; ++m) _Pragma("unroll") for (int n = 0; n < 2; ++n) _Pragma("unroll") for (int k = 0; k < 2; ++k) \
        acc[ai][bj][m][n] = __builtin_amdgcn_mfma_f32_16x16x32_bf16(Bt[n][k], At[m][k], acc[ai][bj][m][n], 0, 0, 0); __builtin_amdgcn_s_setprio(0); } while (0)
#define PG8_WAIT_V(n) asm volatile("s_waitcnt vmcnt(" #n ")" ::: "memory")
#define PG8_WAIT_L(n) asm volatile("s_waitcnt lgkmcnt(" #n ")" ::: "memory")
#define PG8_BAR __builtin_amdgcn_s_barrier()
#define PG8_SCHED __builtin_amdgcn_sched_barrier(0)
    Unit cur, nxt; int ui = 0;
    if (!S.next(0, cur)) return;
    f32x4 acc[2][2][4][2];
#pragma unroll
    for (int a = 0; a < 2; ++a)
#pragma unroll
        for (int b = 0; b < 2; ++b)
#pragma unroll
            for (int m = 0; m < 4; ++m)
#pragma unroll
                for (int n = 0; n < 2; ++n) acc[a][b][m][n] = (f32x4){0.f, 0.f, 0.f, 0.f};
    bf16x8 At[4][2], B0[2][2], B1[2][2];
    const char* cA = (const char*)g.A + (size_t)cur.pm * tstepA + (size_t)((cur.pn >> g.ash) * g.amul) * 2; const char* cB = (const char*)g.Bt + (size_t)cur.pn * tstepB;
    PG8_STAGE(PG8_SB(0, 0), cB, voffB); PG8_STAGE(PG8_SB(0, 1), cB + hstepB, voffB); PG8_STAGE(PG8_SA(0, 0), cA, voffA); PG8_STAGE(PG8_SA(0, 1), cA + hstepA, voffA);
    if (wr == 1) PG8_BAR;
    PG8_WAIT_V(2); PG8_BAR;
    PG8_STAGE(PG8_SB(1, 0), cB + kstep, voffB); PG8_STAGE(PG8_SA(1, 0), cA + kstep, voffA); PG8_STAGE(PG8_SB(1, 1), cB + hstepB + kstep, voffB);
    PG8_WAIT_V(6); PG8_BAR;
#define PG8_KLOOP() do { \
        _Pragma("unroll 1") \
        for (int t = 0; t < nt; t += 2) { \
            const bool last = (t == nt - 2); \
            const char* a1 = cA + (size_t)(t + 1) * kstep; \
            const char* a2 = last ? nA : cA + (size_t)(t + 2) * kstep; const char* b2 = last ? nB : cB + (size_t)(t + 2) * kstep; \
            const char* a3 = a2 + kstep; const char* b3 = b2 + kstep; \
            PG8_LDB(B0, 0, 0); PG8_LDB(B1, 0, 1); PG8_SCHED; PG8_LDA(At, 0, 0); PG8_STAGE(PG8_SA(1, 1), a1 + hstepA, voffA); \
            PG8_WAIT_V(8); PG8_WAIT_L(0); PG8_BAR; PG8_MMA(0, 0, At, B0); PG8_MMA(0, 1, At, B1); PG8_BAR; PG8_SCHED; \
            PG8_LDA(At, 0, 1); PG8_STAGE(PG8_SB(0, 0), b2, voffB); PG8_STAGE(PG8_SB(0, 1), b2 + hstepB, voffB); PG8_STAGE(PG8_SA(0, 0), a2, voffA); \
            PG8_WAIT_V(8); PG8_WAIT_L(0); PG8_BAR; PG8_MMA(1, 0, At, B0); PG8_MMA(1, 1, At, B1); PG8_BAR; PG8_SCHED; \
            PG8_LDB(B0, 1, 0); PG8_LDB(B1, 1, 1); PG8_SCHED; PG8_LDA(At, 1, 0); PG8_STAGE(PG8_SA(0, 1), a2 + hstepA, voffA); \
            PG8_WAIT_V(8); PG8_WAIT_L(0); PG8_BAR; PG8_MMA(0, 0, At, B0); PG8_MMA(0, 1, At, B1); PG8_BAR; PG8_SCHED; \
            PG8_LDA(At, 1, 1); PG8_STAGE(PG8_SB(1, 0), b3, voffB); PG8_STAGE(PG8_SB(1, 1), b3 + hstepB, voffB); PG8_STAGE(PG8_SA(1, 0), a3, voffA); \
            PG8_WAIT_V(8); PG8_WAIT_L(0); PG8_BAR; PG8_MMA(1, 0, At, B0); PG8_MMA(1, 1, At, B1); PG8_BAR; PG8_SCHED; \
        } \
    } while (0)
    for (;;) {
        if constexpr (NSEG > 1) {
            const char* nA = (const char*)g.A2 + (size_t)cur.pm * tstepA + (size_t)((cur.pn >> g.ash) * g.amul) * 2; const char* nB = (const char*)g.Bt2 + (size_t)cur.pn * tstepB;
            PG8_KLOOP();
            if (wr == 0) PG8_BAR;
            E.mid(acc, cur, wr, wc, fr, fq);
            cA = nA; cB = nB;
            if (wr == 1) PG8_BAR;
        }
        const bool has_next = S.next(ui + 1, nxt);
        const char* nA = has_next ? (const char*)g.A + (size_t)nxt.pm * tstepA + (size_t)((nxt.pn >> g.ash) * g.amul) * 2 : cA; const char* nB = has_next ? (const char*)g.Bt + (size_t)nxt.pn * tstepB : cB;
        PG8_KLOOP();
        if (wr == 0) PG8_BAR;
        E(acc, cur, wr, wc, fr, fq);
        if (!has_next) break;
#pragma unroll
        for (int a = 0; a < 2; ++a)
#pragma unroll
            for (int b = 0; b < 2; ++b)
#pragma unroll
                for (int m = 0; m < 4; ++m)
#pragma unroll
                    for (int n = 0; n < 2; ++n) acc[a][b][m][n] = (f32x4){0.f, 0.f, 0.f, 0.f};
        cur = nxt; cA = nA; cB = nB; ++ui;
        if (wr == 1) PG8_BAR;
    }
    PG8_WAIT_V(0);
    PG8_BAR;
#undef PG8_KLOOP
#undef PG8_SA
#undef PG8_SB
#undef PG8_STAGE
#undef PG8_LDA
#undef PG8_LDB
#undef PG8_MMA
#undef PG8_WAIT_V
#undef PG8_WAIT_L
#undef PG8_BAR
#undef PG8_SCHED
}
}
using pg8::Unit;

typedef f32x4 AccT[2][2][4][2];

struct EpiIn {
    static constexpr bool PERM = true;
    bf16_t* Z; const float* bias; const float* ss; int stage; LAS float* rl;
    __device__ __forceinline__ void operator()(const AccT& acc, const Unit& u, int wr, int wc, int fr, int fq) const {
        const int row0 = u.pm * 256 + wr * 64 + fr;
        float rs[8]; rstd8_cached(rs, ss, (stage << 8) | u.pm, u.pm, rl, wr, wc, fr, fq);
        if (u.pn >= 24 && u.pn < 40) {
            const int ch0 = (u.pn - 24) * 128 + wc * 32 + 8 * fq;
            f32x4 bc[2], bx[2];
#pragma unroll
            for (int n = 0; n < 2; ++n) { bc[n] = *(const f32x4*)(bias + 3 * D + ch0 + 4 * n); bx[n] = *(const f32x4*)(bias + 4 * D + ch0 + 4 * n); }
            bf16_t* base = Z + 3 * SEC;
#pragma unroll
            for (int ai = 0; ai < 2; ++ai)
#pragma unroll
                for (int m = 0; m < 4; ++m) { const int row = row0 + ai * 128 + m * 16;
                    const float rstd = rs[ai * 4 + m];
                    const f32x4 v0 = (acc[ai][0][m][0] * rstd + bc[0]) * (acc[ai][1][m][0] * rstd + bx[0]), v1 = (acc[ai][0][m][1] * rstd + bc[1]) * (acc[ai][1][m][1] * rstd + bx[1]);
                    u32x4 w; w.x = cvt_pk_bf16(v0[0], v0[1]); w.y = cvt_pk_bf16(v0[2], v0[3]); w.z = cvt_pk_bf16(v1[0], v1[1]); w.w = cvt_pk_bf16(v1[2], v1[3]);
                    *(u32x4*)(base + (size_t)row * D + ch0) = w; }
            return;
        }
        if (u.pn >= 40) {
            const int ch0 = (u.pn - 40) * 128 + wc * 32 + 8 * fq;
            f32x4 ba[2], bb[2];
#pragma unroll
            for (int n = 0; n < 2; ++n) { ba[n] = *(const f32x4*)(bias + 5 * D + ch0 + 4 * n); bb[n] = *(const f32x4*)(bias + 6 * D + ch0 + 4 * n); }
#pragma unroll
            for (int ai = 0; ai < 2; ++ai)
#pragma unroll
                for (int m = 0; m < 4; ++m) { const int row = row0 + ai * 128 + m * 16;
                    const float rstd = rs[ai * 4 + m];
                    f32x4 rt[2], sb[2];
#pragma unroll
                    for (int n = 0; n < 2; ++n)
#pragma unroll
                        for (int j = 0; j < 4; ++j) { const float ea = __builtin_amdgcn_exp2f(-LOG2E * (acc[ai][0][m][n][j] * rstd + ba[n][j])), eb = __builtin_amdgcn_exp2f(-LOG2E * (acc[ai][1][m][n][j] * rstd + bb[n][j]));
                            sb[n][j] = __builtin_amdgcn_rcpf(1.0f + eb); rt[n][j] = (1.0f + eb) * __builtin_amdgcn_rcpf(1.0f + ea); }
                    u32x4 w; w.x = cvt_pk_bf16(rt[0][0], rt[0][1]); w.y = cvt_pk_bf16(rt[0][2], rt[0][3]); w.z = cvt_pk_bf16(rt[1][0], rt[1][1]); w.w = cvt_pk_bf16(rt[1][2], rt[1][3]);
                    *(u32x4*)(Z + 5 * SEC + (size_t)row * D + ch0) = w;
                    u32x4 v; v.x = cvt_pk_bf16(sb[0][0], sb[0][1]); v.y = cvt_pk_bf16(sb[0][2], sb[0][3]); v.z = cvt_pk_bf16(sb[1][0], sb[1][1]); v.w = cvt_pk_bf16(sb[1][2], sb[1][3]);
                    *(u32x4*)(Z + 6 * SEC + (size_t)row * D + ch0) = v; }
            return;
        }
        const int s = u.pn >> 3; const int colt = (u.pn & 7) * 256;
        bf16_t* base = Z + (size_t)s * SEC;
        const int col0 = colt + wc * 32 + 8 * fq, bcol0 = s * D + col0;
        f32x4 bv[2][2];
#pragma unroll
        for (int bj = 0; bj < 2; ++bj)
#pragma unroll
            for (int n = 0; n < 2; ++n) bv[bj][n] = *(const f32x4*)(bias + bcol0 + bj * 128 + 4 * n);
#pragma unroll
        for (int ai = 0; ai < 2; ++ai)
#pragma unroll
            for (int m = 0; m < 4; ++m) { bf16_t* rowp = base + (size_t)(row0 + ai * 128 + m * 16) * D + col0;
                const float rstd = rs[ai * 4 + m];
#pragma unroll
                for (int bj = 0; bj < 2; ++bj) { f32x4 v0 = acc[ai][bj][m][0] * rstd + bv[bj][0], v1 = acc[ai][bj][m][1] * rstd + bv[bj][1];
                    u32x4 w; w.x = cvt_pk_bf16(v0[0], v0[1]); w.y = cvt_pk_bf16(v0[2], v0[3]); w.z = cvt_pk_bf16(v1[0], v1[1]); w.w = cvt_pk_bf16(v1[2], v1[3]);
                    *(u32x4*)(rowp + bj * 128) = w; } }
    }
};

struct EpiGate {
    static constexpr bool PERM = true;
    const bf16_t* XC; bf16_t* LA; bf16_t* BV; const float* br; const float* bi; const float* c8p;
    __device__ __forceinline__ void operator()(const AccT& acc, const Unit& u, int wr, int wc, int fr, int fq) const {
        const int row0 = u.pm * 256 + wr * 64 + fr, ch0 = u.pn * 128 + wc * 32 + 8 * fq;
        f32x4 brv[2], biv[2], c8[2];
#pragma unroll
        for (int n = 0; n < 2; ++n) { brv[n] = *(const f32x4*)(br + ch0 + 4 * n); biv[n] = *(const f32x4*)(bi + ch0 + 4 * n); c8[n] = *(const f32x4*)(c8p + ch0 + 4 * n); }
        u32x4 xw4[8];
#pragma unroll
        for (int q = 0; q < 8; ++q) xw4[q] = *(const u32x4*)(XC + (size_t)(row0 + (q >> 2) * 128 + (q & 3) * 16) * D + ch0);
#pragma unroll
        for (int ai = 0; ai < 2; ++ai)
#pragma unroll
            for (int m = 0; m < 4; ++m) { const size_t off = (size_t)(row0 + ai * 128 + m * 16) * D + ch0;
                const u32x4 xq = xw4[ai * 4 + m];
                const float xv[8] = {bf_lo(xq.x), bf_hi(xq.x), bf_lo(xq.y), bf_hi(xq.y), bf_lo(xq.z), bf_hi(xq.z), bf_lo(xq.w), bf_hi(xq.w)};
                float lo[8], bo[8];
#pragma unroll
                for (int n = 0; n < 2; ++n)
#pragma unroll
                    for (int j = 0; j < 4; ++j) { const float r = fast_sigmoid(acc[ai][0][m][n][j] + brv[n][j]), ig = fast_sigmoid(acc[ai][1][m][n][j] + biv[n][j]);
                        const float la = c8[n][j] * r; const float a2 = __builtin_amdgcn_exp2f(2.0f * la);
                        const float mult = __builtin_amdgcn_sqrtf(fmaxf(1.0f - a2, 0.0f));
                        lo[n * 4 + j] = la; bo[n * 4 + j] = mult * ig * xv[n * 4 + j]; }
                u32x4 w; w.x = cvt_pk_bf16(lo[0], lo[1]); w.y = cvt_pk_bf16(lo[2], lo[3]); w.z = cvt_pk_bf16(lo[4], lo[5]); w.w = cvt_pk_bf16(lo[6], lo[7]);
                *(u32x4*)(LA + off) = w;
                u32x4 v; v.x = cvt_pk_bf16(bo[0], bo[1]); v.y = cvt_pk_bf16(bo[2], bo[3]); v.z = cvt_pk_bf16(bo[4], bo[5]); v.w = cvt_pk_bf16(bo[6], bo[7]);
                *(u32x4*)(BV + off) = v; }
    }
};

struct EpiMerge2 {
    static constexpr bool PERM = true;
    bf16_t* RT; const bf16_t* GB;
    __device__ __forceinline__ void mid(AccT& acc, const Unit& u, int wr, int wc, int fr, int fq) const {
        const int row0 = u.pm * 256 + wr * 64 + fr, col0 = u.pn * 256 + wc * 32 + 8 * fq;
#pragma unroll
        for (int q = 0; q < 4; ++q) { const int ai = q >> 1, m0 = (q & 1) * 2;
            u32x4 rw[2][2];
#pragma unroll
            for (int mm = 0; mm < 2; ++mm)
#pragma unroll
                for (int bj = 0; bj < 2; ++bj) rw[mm][bj] = *(const u32x4*)(RT + (size_t)(row0 + ai * 128 + (m0 + mm) * 16) * D + col0 + bj * 128);
#pragma unroll
            for (int mm = 0; mm < 2; ++mm)
#pragma unroll
                for (int bj = 0; bj < 2; ++bj) { const u32x4 r = rw[mm][bj]; const int m = m0 + mm;
                    acc[ai][bj][m][0] *= (f32x4){bf_lo(r.x), bf_hi(r.x), bf_lo(r.y), bf_hi(r.y)}; acc[ai][bj][m][1] *= (f32x4){bf_lo(r.z), bf_hi(r.z), bf_lo(r.w), bf_hi(r.w)}; }
            asm volatile("" ::: "memory"); __builtin_amdgcn_sched_barrier(0);
        }
    }
    __device__ __forceinline__ void operator()(const AccT& acc, const Unit& u, int wr, int wc, int fr, int fq) const {
        const int row0 = u.pm * 256 + wr * 64 + fr, col0 = u.pn * 256 + wc * 32 + 8 * fq;
#pragma unroll
        for (int ai = 0; ai < 2; ++ai) {
            u32x4 gb[4][2];
#pragma unroll
            for (int m = 0; m < 4; ++m)
#pragma unroll
                for (int bj = 0; bj < 2; ++bj) gb[m][bj] = __builtin_nontemporal_load((const u32x4*)(GB + (size_t)(row0 + ai * 128 + m * 16) * D + col0 + bj * 128));
#pragma unroll
            for (int m = 0; m < 4; ++m)
#pragma unroll
                for (int bj = 0; bj < 2; ++bj) { const u32x4 b = gb[m][bj];
                    const f32x4 v0 = acc[ai][bj][m][0] * (f32x4){bf_lo(b.x), bf_hi(b.x), bf_lo(b.y), bf_hi(b.y)}, v1 = acc[ai][bj][m][1] * (f32x4){bf_lo(b.z), bf_hi(b.z), bf_lo(b.w), bf_hi(b.w)};
                    u32x4 w; w.x = cvt_pk_bf16(v0[0], v0[1]); w.y = cvt_pk_bf16(v0[2], v0[3]); w.z = cvt_pk_bf16(v1[0], v1[1]); w.w = cvt_pk_bf16(v1[2], v1[3]);
                    *(u32x4*)(RT + (size_t)(row0 + ai * 128 + m * 16) * D + col0 + bj * 128) = w; }
        }
    }
};

struct EpiResid {
    static constexpr bool PERM = true;
    const void* base; void* out; float* ss; bool base_bf16, out_f32; LAS float* red;
    __device__ __forceinline__ void operator()(const AccT& acc, const Unit& u, int wr, int wc, int fr, int fq) const {
        const int row0 = u.pm * 256 + wr * 64 + fr, col0 = u.pn * 256 + wc * 32 + 8 * fq;
#pragma unroll
        for (int ai = 0; ai < 2; ++ai) {
            f32x4 bs[4][2][2];
            if (base_bf16) {
                const bf16_t* bp = (const bf16_t*)base;
                u32x4 raw[4][2];
#pragma unroll
                for (int m = 0; m < 4; ++m)
#pragma unroll
                    for (int bj = 0; bj < 2; ++bj) raw[m][bj] = *(const u32x4*)(bp + (size_t)(row0 + ai * 128 + m * 16) * D + col0 + bj * 128);
#pragma unroll
                for (int m = 0; m < 4; ++m)
#pragma unroll
                    for (int bj = 0; bj < 2; ++bj) { const u32x4 r = raw[m][bj]; bs[m][bj][0] = (f32x4){bf_lo(r.x), bf_hi(r.x), bf_lo(r.y), bf_hi(r.y)}; bs[m][bj][1] = (f32x4){bf_lo(r.z), bf_hi(r.z), bf_lo(r.w), bf_hi(r.w)}; }
            } else {
                const float* bp = (const float*)base;
#pragma unroll
                for (int m = 0; m < 4; ++m)
#pragma unroll
                    for (int bj = 0; bj < 2; ++bj) { const size_t off = (size_t)(row0 + ai * 128 + m * 16) * D + col0 + bj * 128; bs[m][bj][0] = *(const f32x4*)(bp + off); bs[m][bj][1] = *(const f32x4*)(bp + off + 4); }
            }
#pragma unroll
            for (int m = 0; m < 4; ++m) { const int row = row0 + ai * 128 + m * 16; const size_t off = (size_t)row * D + col0; float sq = 0.f;
#pragma unroll
                for (int bj = 0; bj < 2; ++bj) {
                    const f32x4 v0 = bs[m][bj][0] + acc[ai][bj][m][0], v1 = bs[m][bj][1] + acc[ai][bj][m][1];
                    sq += (v0[0] * v0[0] + v0[1] * v0[1]) + (v0[2] * v0[2] + v0[3] * v0[3]) + (v1[0] * v1[0] + v1[1] * v1[1]) + (v1[2] * v1[2] + v1[3] * v1[3]);
                    if (out_f32) { float* op = (float*)out; *(f32x4*)(op + off + bj * 128) = v0; *(f32x4*)(op + off + bj * 128 + 4) = v1; }
                    else { u32x4 w; w.x = cvt_pk_bf16(v0[0], v0[1]); w.y = cvt_pk_bf16(v0[2], v0[3]); w.z = cvt_pk_bf16(v1[0], v1[1]); w.w = cvt_pk_bf16(v1[2], v1[3]);
                        *(u32x4*)((bf16_t*)out + off + bj * 128) = w; } }
                sq += __shfl_xor(sq, 16); sq += __shfl_xor(sq, 32);
                if (fq == 0) red[(ai * 128 + wr * 64 + m * 16 + fr) * 4 + wc] = sq; }
            asm volatile("" ::: "memory"); }
        asm volatile("s_waitcnt lgkmcnt(0)" ::: "memory"); __builtin_amdgcn_s_barrier(); asm volatile("" ::: "memory");
        { const int t = (wr * 4 + wc) * 64 + fq * 16 + fr; if (t < 256) { const f32x4 p = *(const LAS f32x4*)(red + t * 4); ss[(size_t)(u.pm * 256 + t) * 8 + u.pn] = (p.x + p.y) + (p.z + p.w); } }
    }
};

struct EpiFinal {
    static constexpr bool PERM = true;
    const bf16_t* base; float* out; float* ssp; const float* gain; LAS float* red; XcdBarrier xb; bool xlocal;
    __device__ __forceinline__ void operator()(AccT& acc, const Unit& u, int wr, int wc, int fr, int fq) const {
        const int row0 = u.pm * 256 + wr * 64 + fr, col0 = u.pn * 256 + wc * 32 + 8 * fq;
#pragma unroll
        for (int ai = 0; ai < 2; ++ai) {
            u32x4 raw[4][2];
#pragma unroll
            for (int m = 0; m < 4; ++m)
#pragma unroll
                for (int bj = 0; bj < 2; ++bj) raw[m][bj] = *(const u32x4*)(base + (size_t)(row0 + ai * 128 + m * 16) * D + col0 + bj * 128);
#pragma unroll
            for (int m = 0; m < 4; ++m) { float sq = 0.f;
#pragma unroll
                for (int bj = 0; bj < 2; ++bj) { const u32x4 r = raw[m][bj];
                    const f32x4 v0 = (f32x4){bf_lo(r.x), bf_hi(r.x), bf_lo(r.y), bf_hi(r.y)} + acc[ai][bj][m][0], v1 = (f32x4){bf_lo(r.z), bf_hi(r.z), bf_lo(r.w), bf_hi(r.w)} + acc[ai][bj][m][1];
                    acc[ai][bj][m][0] = v0; acc[ai][bj][m][1] = v1;
                    sq += (v0[0] * v0[0] + v0[1] * v0[1]) + (v0[2] * v0[2] + v0[3] * v0[3]) + (v1[0] * v1[0] + v1[1] * v1[1]) + (v1[2] * v1[2] + v1[3] * v1[3]); }
                sq += __shfl_xor(sq, 16); sq += __shfl_xor(sq, 32);
                if (fq == 0) red[(ai * 128 + wr * 64 + m * 16 + fr) * 4 + wc] = sq; }
        }
        asm volatile("s_waitcnt lgkmcnt(0)" ::: "memory"); __builtin_amdgcn_s_barrier(); asm volatile("" ::: "memory");
        { const int t = (wr * 4 + wc) * 64 + fq * 16 + fr; if (t < 256) { const f32x4 p = *(const LAS f32x4*)(red + t * 4); ssp[(size_t)(u.pm * 256 + t) * 8 + u.pn] = (p.x + p.y) + (p.z + p.w); } }
        if (xlocal) xcd_local_barrier(xb); else xcd_barrier(xb);
        f32x4 gv[2][2];
#pragma unroll
        for (int bj = 0; bj < 2; ++bj) { gv[bj][0] = *(const f32x4*)(gain + col0 + bj * 128); gv[bj][1] = *(const f32x4*)(gain + col0 + bj * 128 + 4); }
        float rs[8]; rstd8(rs, ssp, row0);
#pragma unroll
        for (int ai = 0; ai < 2; ++ai)
#pragma unroll
            for (int m = 0; m < 4; ++m) { const int row = row0 + ai * 128 + m * 16; const float rstd = rs[ai * 4 + m];
#pragma unroll
                for (int bj = 0; bj < 2; ++bj) { float* op = out + (size_t)row * D + col0 + bj * 128;
                    *(f32x4*)op = acc[ai][bj][m][0] * rstd * gv[bj][0]; *(f32x4*)(op + 4) = acc[ai][bj][m][1] * rstd * gv[bj][1]; } }
    }
};

struct EpiRelu2 {
    static constexpr bool PERM = true;
    bf16_t* U; const float* ss; int stage; LAS float* rl;
    __device__ __forceinline__ void operator()(const AccT& acc, const Unit& u, int wr, int wc, int fr, int fq) const {
        const int row0 = u.pm * 256 + wr * 64 + fr, col0 = u.pn * 256 + wc * 32 + 8 * fq;
        float rs[8]; rstd8_cached(rs, ss, (stage << 8) | u.pm, u.pm, rl, wr, wc, fr, fq);
#pragma unroll
        for (int ai = 0; ai < 2; ++ai)
#pragma unroll
            for (int m = 0; m < 4; ++m) { bf16_t* rowp = U + (size_t)(row0 + ai * 128 + m * 16) * FF + col0;
                const float rstd = rs[ai * 4 + m];
#pragma unroll
                for (int bj = 0; bj < 2; ++bj) { f32x4 v0 = acc[ai][bj][m][0], v1 = acc[ai][bj][m][1];
#pragma unroll
                    for (int j = 0; j < 4; ++j) { const float a = fmaxf(v0[j], 0.f) * rstd, b = fmaxf(v1[j], 0.f) * rstd; v0[j] = a * a; v1[j] = b * b; }
                    u32x4 w; w.x = cvt_pk_bf16(v0[0], v0[1]); w.y = cvt_pk_bf16(v0[2], v0[3]); w.z = cvt_pk_bf16(v1[0], v1[1]); w.w = cvt_pk_bf16(v1[2], v1[3]);
                    *(u32x4*)(rowp + bj * 128) = w; } }
    }
};

struct TItem { const float* src; bf16_t* dst; const float* gs; int N, K; };
constexpr int I_IN = (D / 64) * (NIN / 32), I_G = 2 * 8 * (256 / 64) * (256 / 32), I_P = (D / 64) * (D / 32), I_1 = (D / 64) * (FF / 32), I_2 = (FF / 64) * (D / 32);
constexpr int PER_LAYER = I_IN + I_G + 3 * I_P + I_1 + I_2;

struct Args { const float* in[19]; float* out; unsigned char* ws; };
typedef __attribute__((address_space(4))) Args KArgs;

__device__ __forceinline__ void rms_phase(const float* x, const float* g, bf16_t* out, int gw, int NGW, int lane) {
    for (int m = gw; m < M; m += NGW) {
        const f32x4* xr = (const f32x4*)(x + (size_t)m * D) + lane;
        f32x4 v[8]; float s = 0.f;
#pragma unroll
        for (int j = 0; j < 8; ++j) { v[j] = xr[64 * j]; s += (v[j].x * v[j].x + v[j].y * v[j].y) + (v[j].z * v[j].z + v[j].w * v[j].w); }
        const float rstd = rsqrtf(wave_sum(s) * (1.f / D) + EPS);
        u32x2* o = (u32x2*)(out + (size_t)m * D) + lane;
#pragma unroll
        for (int j = 0; j < 8; ++j) { const f32x4 gv = ((const f32x4*)g)[lane + 64 * j]; const f32x4 y = v[j] * rstd * gv; u32x2 w; w.x = cvt_pk_bf16(y.x, y.y); w.y = cvt_pk_bf16(y.z, y.w); o[64 * j] = w; }
    }
}
#define UNPK8(dst, p) do { dst[0] = bf_lo(p.x); dst[1] = bf_hi(p.x); dst[2] = bf_lo(p.y); dst[3] = bf_hi(p.y); dst[4] = bf_lo(p.z); dst[5] = bf_hi(p.z); dst[6] = bf_lo(p.w); dst[7] = bf_hi(p.w); } while (0)
#define UNPKMUL8(dst, p, q) do { dst[0] = bf_lo(p.x) * bf_lo(q.x); dst[1] = bf_hi(p.x) * bf_hi(q.x); dst[2] = bf_lo(p.y) * bf_lo(q.y); dst[3] = bf_hi(p.y) * bf_hi(q.y); \
    dst[4] = bf_lo(p.z) * bf_lo(q.z); dst[5] = bf_hi(p.z) * bf_hi(q.z); dst[6] = bf_lo(p.w) * bf_lo(q.w); dst[7] = bf_hi(p.w) * bf_hi(q.w); } while (0)
#define LD8F(dst, ptr) do { const f32x4 _p = *(const f32x4*)(ptr), _q = *(const f32x4*)((ptr) + 4); dst[0] = _p.x; dst[1] = _p.y; dst[2] = _p.z; dst[3] = _p.w; dst[4] = _q.x; dst[5] = _q.y; dst[6] = _q.z; dst[7] = _q.w; } while (0)

__global__ void __launch_bounds__(512, 2) fwd_megakernel(Args a_unused) {
    extern __shared__ __attribute__((aligned(16))) unsigned char lds_raw[];
    cg::grid_group grid = cg::this_grid();
    LAS unsigned char* lds = (LAS unsigned char*)lds_raw;
    const int G = gridDim.x, NGW = G * 8, NGT = G * 512;
    const int wave_s = __builtin_amdgcn_readfirstlane((int)(threadIdx.x >> 6));
#define MY_TID() (wave_s * 64 + lane_id())
    volatile LAS unsigned* bst = (volatile LAS unsigned*)(lds + 131072 + 64);
    if (MY_TID() < 4) bst[MY_TID()] = 0u;
    if (MY_TID() == 0) ((volatile LAS int*)(lds + 131072 + 8192))[0] = -1;
    __syncthreads();
    XcdBarrier xbar;
    { KArgs* ap0 = (KArgs*)__builtin_amdgcn_kernarg_segment_ptr(); xbar = xcd_barrier_post((unsigned*)ap0->ws, bst); xbar.wave = wave_s; if (MY_TID() == 0) (void)xb_add(&xbar.bar[XB_XCNT(xbar.x)], 1u); }
    if (MY_TID() == 0) { unsigned* ctl = (unsigned*)((KArgs*)__builtin_amdgcn_kernarg_segment_ptr())->ws; bst[2] = xb_add(&ctl[3584 + 64 * xbar.x], 1u); }
#define LOCAL_BAR() do { if (xlocal) xcd_local_barrier(xbar); else xcd_barrier(xbar); } while (0)
#define GRID_BAR() do { for (int _r = 0; _r < REP_BAR; ++_r) xcd_barrier(xbar); } while (0)
#define PHASE_IDS() int tid = MY_TID(); asm volatile("" : "+v"(tid)); const int lane = tid & 63, wave = __builtin_amdgcn_readfirstlane(tid >> 6); const int gw = blockIdx.x * 8 + wave, gt = blockIdx.x * 512 + tid; (void)lane; (void)gw; (void)gt; (void)wave
#define PHASE_IDS_V() int tid = MY_TID(); asm volatile("" : "+v"(tid)); const int lane = tid & 63, wave = __builtin_amdgcn_readfirstlane(tid >> 6); const int gt = vb * 512 + tid; (void)lane; (void)wave
#define ARGS() KArgs* ap = (KArgs*)__builtin_amdgcn_kernarg_segment_ptr(); asm volatile("" : "+s"(ap)); unsigned char* ws = ap->ws; (void)ws

    {
        PHASE_IDS(); ARGS();
#define DECODE_ITEM(T, itv) do { const int _it = (itv); const int l = _it / PER_LAYER; int r = _it % PER_LAYER; unsigned char* wl = ws + WS_W + (size_t)l * LW; \
            const float* W; bf16_t* WT; const float* gs_ = nullptr; int K_, N_, k0, n0, drow0; \
            if (r < I_IN) { gs_ = ap->in[1] + (size_t)l * D; W = ap->in[2] + (size_t)l * D * NIN; WT = (bf16_t*)(wl + OW_IN); K_ = D; N_ = NIN; k0 = 64 * (r / (NIN / 32)); n0 = 32 * (r % (NIN / 32)); { const int sec_ = n0 >> 11, c0_ = n0 & 2047; drow0 = (sec_ == 3 || sec_ == 4) ? 256 * (24 + (c0_ >> 7)) + (c0_ & 127) + (sec_ == 4 ? 128 : 0) : ((sec_ >= 5) ? 256 * (40 + (c0_ >> 7)) + (c0_ & 127) + (sec_ == 6 ? 128 : 0) : n0); } } \
            else if ((r -= I_IN) < I_G) { const int which = r / 256, nb = (r / 32) & 7, kb = (r & 31) / 8, nblk = r & 7; \
                W = (which ? ap->in[8] : ap->in[6]) + (size_t)l * 8 * 256 * 256 + (size_t)nb * 256 * 256; WT = (bf16_t*)(wl + OW_G); K_ = 256; N_ = 256; k0 = 64 * kb; n0 = 32 * nblk; \
                const int c0 = nb * 256 + nblk * 32; drow0 = 256 * (c0 >> 7) + (c0 & 127) + (which ? 128 : 0); } \
            else if ((r -= I_G) < 3 * I_P) { const int w3 = r / I_P; r -= w3 * I_P; W = (w3 == 0 ? ap->in[12] : (w3 == 1 ? ap->in[13] : ap->in[14])) + (size_t)l * D * D; \
                WT = (bf16_t*)(wl + (w3 == 0 ? OW_PA : (w3 == 1 ? OW_PB : OW_O))); K_ = D; N_ = D; k0 = 64 * (r / (D / 32)); n0 = 32 * (r % (D / 32)); drow0 = n0; } \
            else if ((r -= 3 * I_P) < I_1) { gs_ = ap->in[15] + (size_t)l * D; W = ap->in[16] + (size_t)l * D * FF; WT = (bf16_t*)(wl + OW_1); K_ = D; N_ = FF; k0 = 64 * (r / (FF / 32)); n0 = 32 * (r % (FF / 32)); drow0 = n0; } \
            else { r -= I_1; W = ap->in[17] + (size_t)l * FF * D; WT = (bf16_t*)(wl + OW_2); K_ = FF; N_ = D; k0 = 64 * (r / (D / 32)); n0 = 32 * (r % (D / 32)); drow0 = n0; } \
            const int kg = lane >> 3, nl = lane & 7; \
            T.src = W + (size_t)(k0 + 8 * kg) * N_ + n0 + 4 * nl; T.dst = WT + (size_t)(drow0 + 4 * nl) * K_ + k0 + 8 * kg; T.gs = gs_ ? gs_ + k0 + 8 * kg : nullptr; T.N = N_; T.K = K_; } while (0)
#define STORE_ITEM(T, v) do { _Pragma("unroll") for (int j = 0; j < 4; ++j) { u32x4 o; o.x = cvt_pk_bf16(v[0][j], v[1][j]); o.y = cvt_pk_bf16(v[2][j], v[3][j]); o.z = cvt_pk_bf16(v[4][j], v[5][j]); o.w = cvt_pk_bf16(v[6][j], v[7][j]); \
            *(u32x4*)(T.dst + (size_t)j * T.K) = o; } } while (0)
        for (int rep = 0; rep < REP_P0; ++rep)
        for (int it = gw; it < DEPTH * PER_LAYER; it += 2 * NGW) {
            const bool has1 = (it + NGW) < DEPTH * PER_LAYER;
            TItem t0, t1; DECODE_ITEM(t0, it); DECODE_ITEM(t1, has1 ? it + NGW : it);
            f32x4 v0[8], v1[8];
#pragma unroll
            for (int i = 0; i < 8; ++i) v0[i] = __builtin_nontemporal_load((const f32x4*)(t0.src + (size_t)i * t0.N));
#pragma unroll
            for (int i = 0; i < 8; ++i) v1[i] = __builtin_nontemporal_load((const f32x4*)(t1.src + (size_t)i * t1.N));
            if (t0.gs) { float gq[8]; LD8F(gq, t0.gs);
#pragma unroll
                for (int i = 0; i < 8; ++i) v0[i] *= gq[i]; }
            if (t1.gs) { float gq[8]; LD8F(gq, t1.gs);
#pragma unroll
                for (int i = 0; i < 8; ++i) v1[i] *= gq[i]; }
            STORE_ITEM(t0, v0);
            if (has1) STORE_ITEM(t1, v1);
        }
        {
            const float* x = ap->in[0]; bf16_t* xb = (bf16_t*)(ws + WS_H); float* ss0 = (float*)(ws + WS_SSP);
            for (int m = gw; m < M; m += NGW) {
                const f32x4* xr = (const f32x4*)(x + (size_t)m * D) + lane;
                f32x4 v[8]; float sq = 0.f;
#pragma unroll
                for (int j = 0; j < 8; ++j) { v[j] = xr[64 * j]; sq += (v[j].x * v[j].x + v[j].y * v[j].y) + (v[j].z * v[j].z + v[j].w * v[j].w); }
                sq = wave_sum(sq);
                u32x2* o = (u32x2*)(xb + (size_t)m * D) + lane;
#pragma unroll
                for (int j = 0; j < 8; ++j) { u32x2 w; w.x = cvt_pk_bf16(v[j].x, v[j].y); w.y = cvt_pk_bf16(v[j].z, v[j].w); o[64 * j] = w; }
                if (lane < 8) ss0[(size_t)m * 8 + lane] = lane == 0 ? sq : 0.f;
            }
        }
        if (gt < DEPTH * D) { const float lv = ap->in[10][gt]; ((float*)(ws + WS_C8))[gt] = -8.0f * LOG2E * log1pf(__expf(-lv)); }
    }
    grid.sync();

    int vcu; bool xlocal;
    {
        unsigned* ctl = (unsigned*)((KArgs*)__builtin_amdgcn_kernarg_segment_ptr())->ws;
        bool even = (G % 8) == 0;
#pragma unroll
        for (int j = 0; j < 8; ++j) even = even && (xb_ld(&ctl[3584 + 64 * j]) == (unsigned)(G / 8));
        vcu = even ? (int)(bst[2] * 8u + xbar.x) : (int)blockIdx.x;
        vcu = __builtin_amdgcn_readfirstlane(vcu);
        xlocal = even;
    }
    const int vb = xlocal ? (vcu & 7) * (G >> 3) + (vcu >> 3) : (int)blockIdx.x;
#pragma unroll 1
    for (int l = 0; l < DEPTH; ++l) {
        {
            ARGS();
            pg8::Gemm g{(l == 0) ? (const bf16_t*)(ws + WS_H) : (const bf16_t*)ap->out + SEC, (const bf16_t*)(ws + WS_W + (size_t)l * LW + OW_IN), D, D, 0, 0, nullptr, nullptr}; pg8::StaticOrder S; S.init(M, NIN, G, vcu);
            EpiIn E{(bf16_t*)(ws + WS_Z), ap->in[3] + (size_t)l * NIN, (const float*)(ws + WS_SSP) + (size_t)(2 * l) * M * 8, 2 * l + 1, (LAS float*)(lds + 131072 + 8192)};
            for (int rep = 0; rep < REP_G1; ++rep) pg8::gemm_phase<EpiIn>(lds, g, S, E, wave_s);
        }
        GRID_BAR();
        {
            PHASE_IDS_V(); ARGS();
            bf16_t* Z = (bf16_t*)(ws + WS_Z); bf16_t* Hb = (bf16_t*)(ws + WS_H);
            const bf16_t* Zxa = Z; bf16_t* Zcb = Z + 2 * SEC; const bf16_t* Zp = Z + 3 * SEC;
            const float* caw = ap->in[4] + (size_t)l * 4 * D; const float* cab = ap->in[5] + (size_t)l * D; const float* cbw = ap->in[11] + (size_t)l * 3 * D;
            for (int item = gt; item < (M / 32) * (D / 8); item += NGT) {
                const int grp = item & 255, run = item >> 8, t0 = run * 32, c0 = grp * 8;
                const bool first = (t0 % SEQ) == 0;
                {
                    float w0[8], w1[8], w2[8], w3[8], bia[8];
                    LD8F(w0, caw + c0); LD8F(w1, caw + D + c0); LD8F(w2, caw + 2 * D + c0); LD8F(w3, caw + 3 * D + c0); LD8F(bia, cab + c0);
                    float x0[8], x1[8], x2[8];
#pragma unroll
                    for (int j = 0; j < 8; ++j) { x0[j] = 0.f; x1[j] = 0.f; x2[j] = 0.f; }
                    if (!first) {
                        const u32x4 p0 = *(const u32x4*)(Zxa + (size_t)(t0 - 3) * D + c0), p1 = *(const u32x4*)(Zxa + (size_t)(t0 - 2) * D + c0), p2 = *(const u32x4*)(Zxa + (size_t)(t0 - 1) * D + c0);
                        UNPK8(x0, p0); UNPK8(x1, p1); UNPK8(x2, p2);
                    }
                    float sx0[8], sx1[8], sx2[8];
#pragma unroll
                    for (int j = 0; j < 8; ++j) { sx0[j] = x0[j]; sx1[j] = x1[j]; sx2[j] = x2[j]; }
#pragma unroll 1
                    for (int tbr = 0; tbr < 32 * REP_CA; tbr += 8) { const int tb = tbr & 31;
                        if (tb == 0 && tbr != 0) {
#pragma unroll
                            for (int j = 0; j < 8; ++j) { x0[j] = sx0[j]; x1[j] = sx1[j]; x2[j] = sx2[j]; } }
                        u32x4 pv[8];
#pragma unroll
                        for (int t = 0; t < 8; ++t) pv[t] = __builtin_nontemporal_load((const u32x4*)(Zxa + (size_t)(t0 + tb + t) * D + c0));
#pragma unroll
                        for (int t = 0; t < 8; ++t) {
                            float xc[8]; UNPK8(xc, pv[t]);
                            float y[8];
#pragma unroll
                            for (int j = 0; j < 8; ++j) { y[j] = bia[j] + w0[j] * x0[j] + w1[j] * x1[j] + w2[j] * x2[j] + w3[j] * xc[j]; x0[j] = x1[j]; x1[j] = x2[j]; x2[j] = xc[j]; }
                            u32x4 o; o.x = cvt_pk_bf16(y[0], y[1]); o.y = cvt_pk_bf16(y[2], y[3]); o.z = cvt_pk_bf16(y[4], y[5]); o.w = cvt_pk_bf16(y[6], y[7]);
                            *(u32x4*)(Hb + (size_t)(t0 + tb + t) * D + c0) = o;
                        }
                    }
                }
                {
                    float w0[8], w1[8], w2[8];
                    LD8F(w0, cbw + c0); LD8F(w1, cbw + D + c0); LD8F(w2, cbw + 2 * D + c0);
                    float x1[8], x2[8];
#pragma unroll
                    for (int j = 0; j < 8; ++j) { x1[j] = 0.f; x2[j] = 0.f; }
                    if (!first) {
                        const u32x4 p1 = *(const u32x4*)(Zp + (size_t)(t0 - 2) * D + c0), p2 = *(const u32x4*)(Zp + (size_t)(t0 - 1) * D + c0);
                        UNPK8(x1, p1); UNPK8(x2, p2);
                    }
#pragma unroll 1
                    for (int tb = 0; tb < 32; tb += 8) {
                        u32x4 pv[8], bv[8];
#pragma unroll
                        for (int t = 0; t < 8; ++t) { const size_t off = (size_t)(t0 + tb + t) * D + c0; pv[t] = __builtin_nontemporal_load((const u32x4*)(Zp + off)); bv[t] = __builtin_nontemporal_load((const u32x4*)(Zcb + off)); }
#pragma unroll
                        for (int t = 0; t < 8; ++t) {
                            float xc[8]; UNPK8(xc, pv[t]);
                            float cbv[8]; UNPK8(cbv, bv[t]);
                            float y[8];
#pragma unroll
                            for (int j = 0; j < 8; ++j) { y[j] = cbv[j] * (w0[j] * x1[j] + w1[j] * x2[j] + w2[j] * xc[j]); x1[j] = x2[j]; x2[j] = xc[j]; }
                            u32x4 o; o.x = cvt_pk_bf16(y[0], y[1]); o.y = cvt_pk_bf16(y[2], y[3]); o.z = cvt_pk_bf16(y[4], y[5]); o.w = cvt_pk_bf16(y[6], y[7]);
                            *(u32x4*)(Zcb + (size_t)(t0 + tb + t) * D + c0) = o;
                        }
                    }
                }
            }
        }
        LOCAL_BAR();
        {
            ARGS();
            pg8::Gemm g{(const bf16_t*)(ws + WS_H), (const bf16_t*)(ws + WS_W + (size_t)l * LW + OW_G), D, 256, 1, 256, nullptr, nullptr}; pg8::StaticOrder S; S.init(M, 2 * D, G, vcu);
            EpiGate E{(const bf16_t*)(ws + WS_H), (bf16_t*)(ws + WS_Z) + 4 * SEC, (bf16_t*)(ws + WS_B), ap->in[7] + (size_t)l * D, ap->in[9] + (size_t)l * D, (const float*)(ws + WS_C8) + (size_t)l * D};
            for (int rep = 0; rep < REP_G2; ++rep) pg8::gemm_phase<EpiGate>(lds, g, S, E, wave_s);
        }
        LOCAL_BAR();
        {
            PHASE_IDS_V(); ARGS();
            const bf16_t* Zxa = (const bf16_t*)(ws + WS_Z) + 4 * SEC; const bf16_t* Bb = (const bf16_t*)(ws + WS_B); float* AggA = (float*)(ws + WS_AGG); float* AggB = AggA + 256 * D;
            for (int rep = 0; rep < REP_S1; ++rep)
            for (int item = gt; item < (M / 64) * (D / 4); item += NGT) {
                const int grp = item & 511, chunk = item >> 9, t0 = chunk * 64, c0 = grp * 4;
                f32x4 h = {0.f, 0.f, 0.f, 0.f}, P = {0.f, 0.f, 0.f, 0.f};
#pragma unroll 8
                for (int t = 0; t < 64; ++t) {
                    const size_t off = (size_t)(t0 + t) * D + c0;
                    const u32x2 lw = *(const u32x2*)(Zxa + off), bw = *(const u32x2*)(Bb + off);
                    const f32x4 la = {bf_lo(lw.x), bf_hi(lw.x), bf_lo(lw.y), bf_hi(lw.y)}, bv = {bf_lo(bw.x), bf_hi(bw.x), bf_lo(bw.y), bf_hi(bw.y)};
                    f32x4 av; av.x = __builtin_amdgcn_exp2f(la.x); av.y = __builtin_amdgcn_exp2f(la.y); av.z = __builtin_amdgcn_exp2f(la.z); av.w = __builtin_amdgcn_exp2f(la.w);
                    h = av * h + bv; P += la;
                }
                f32x4 Av; Av.x = __builtin_amdgcn_exp2f(P.x); Av.y = __builtin_amdgcn_exp2f(P.y); Av.z = __builtin_amdgcn_exp2f(P.z); Av.w = __builtin_amdgcn_exp2f(P.w);
                *(f32x4*)(AggA + (size_t)chunk * D + c0) = Av; *(f32x4*)(AggB + (size_t)chunk * D + c0) = h;
            }
        }
        GRID_BAR();
        {
            PHASE_IDS_V(); ARGS();
            const bf16_t* Zxa = (const bf16_t*)(ws + WS_Z) + 4 * SEC; const bf16_t* Bb = (const bf16_t*)(ws + WS_B); const float* AggA = (const float*)(ws + WS_AGG); const float* AggB = AggA + 256 * D;
            const bf16_t* Zgy = (const bf16_t*)(ws + WS_Z) + SEC; bf16_t* Zhy = (bf16_t*)(ws + WS_Z) + 3 * SEC;
            for (int rep = 0; rep < REP_S3; ++rep)
            for (int item = gt; item < (M / 64) * (D / 4); item += NGT) {
                const int grp = item & 511, chunk = item >> 9, t0 = chunk * 64, c0 = grp * 4;
                const int cfirst = chunk & ~63;
                f32x4 h = {0.f, 0.f, 0.f, 0.f};
#pragma unroll 1
                for (int cb8 = cfirst; cb8 < chunk; cb8 += 8) {
                    f32x4 Av[8], Bv[8];
#pragma unroll
                    for (int k = 0; k < 8; ++k) { Av[k] = *(const f32x4*)(AggA + (size_t)(cb8 + k) * D + c0); Bv[k] = *(const f32x4*)(AggB + (size_t)(cb8 + k) * D + c0); }
#pragma unroll
                    for (int k = 0; k < 8; ++k) { const bool use = (cb8 + k) < chunk; const f32x4 hn = Av[k] * h + Bv[k]; h = use ? hn : h; }
                }
#pragma unroll 1
                for (int tb = 0; tb < 64; tb += 8) {
                    u32x2 lw[8], bw[8], gv[8];
#pragma unroll
                    for (int t = 0; t < 8; ++t) { const size_t off = (size_t)(t0 + tb + t) * D + c0; lw[t] = __builtin_nontemporal_load((const u32x2*)(Zxa + off)); bw[t] = __builtin_nontemporal_load((const u32x2*)(Bb + off)); gv[t] = __builtin_nontemporal_load((const u32x2*)(Zgy + off)); }
#pragma unroll
                    for (int t = 0; t < 8; ++t) {
                        const f32x4 la = {bf_lo(lw[t].x), bf_hi(lw[t].x), bf_lo(lw[t].y), bf_hi(lw[t].y)}, bv = {bf_lo(bw[t].x), bf_hi(bw[t].x), bf_lo(bw[t].y), bf_hi(bw[t].y)};
                        const f32x4 gy = {gelu_tanh(bf_lo(gv[t].x)), gelu_tanh(bf_hi(gv[t].x)), gelu_tanh(bf_lo(gv[t].y)), gelu_tanh(bf_hi(gv[t].y))};
                        f32x4 av; av.x = __builtin_amdgcn_exp2f(la.x); av.y = __builtin_amdgcn_exp2f(la.y); av.z = __builtin_amdgcn_exp2f(la.z); av.w = __builtin_amdgcn_exp2f(la.w);
                        h = av * h + bv;
                        const f32x4 y = h * gy;
                        u32x2 o; o.x = cvt_pk_bf16(y.x, y.y); o.y = cvt_pk_bf16(y.z, y.w);
                        *(u32x2*)(Zhy + (size_t)(t0 + tb + t) * D + c0) = o;
                    }
                }
            }
        }
        LOCAL_BAR();
        {
            ARGS();
            bf16_t* Z = (bf16_t*)(ws + WS_Z);
            pg8::StaticOrder S; S.init(M, D, G, vcu);
            pg8::Gemm g{Z + 3 * SEC, (const bf16_t*)(ws + WS_W + (size_t)l * LW + OW_PA), D, D, 0, 0, Z + 2 * SEC, (const bf16_t*)(ws + WS_W + (size_t)l * LW + OW_PB)};
            EpiMerge2 E{Z + 5 * SEC, Z + 6 * SEC};
            pg8::gemm_phase<EpiMerge2, 2>(lds, g, S, E, wave_s);
        }
        LOCAL_BAR();
        {
            ARGS();
            pg8::Gemm g{(const bf16_t*)(ws + WS_Z) + 5 * SEC, (const bf16_t*)(ws + WS_W + (size_t)l * LW + OW_O), D, D, 0, 0, nullptr, nullptr}; pg8::StaticOrder S; S.init(M, D, G, vcu);
            bf16_t* R1 = (l + 1 == DEPTH) ? (bf16_t*)(ws + WS_H) : (bf16_t*)ap->out; bf16_t* R2 = (bf16_t*)ap->out + SEC;
            EpiResid E{(l == 0) ? (const void*)ap->in[0] : (const void*)R2, (void*)R1, (float*)(ws + WS_SSP) + (size_t)(2 * l + 1) * M * 8, l != 0, false, (LAS float*)(lds + 131072 + 1024)};
            pg8::gemm_phase<EpiResid>(lds, g, S, E, wave_s);
        }
        LOCAL_BAR();
        {
            const bool split = xlocal && (G % 8 == 0);
            const int ngs = split ? 8 / pg8::WGM : 1;
            const bool lastl = (l + 1 == DEPTH);
#pragma unroll 1
            for (int gs = 0; gs < ngs; ++gs) {
                {
                    ARGS();
                    pg8::Gemm g{lastl ? (const bf16_t*)(ws + WS_H) : (const bf16_t*)ap->out, (const bf16_t*)(ws + WS_W + (size_t)l * LW + OW_1), D, D, 0, 0, nullptr, nullptr}; pg8::StaticOrder S; S.init(M, FF, G, vcu); S.gsel = split ? gs : -1;
                    EpiRelu2 E{(bf16_t*)(ws + WS_Z), (const float*)(ws + WS_SSP) + (size_t)(2 * l + 1) * M * 8, 2 * l + 2, (LAS float*)(lds + 131072 + 8192)};
                    pg8::gemm_phase<EpiRelu2>(lds, g, S, E, wave_s);
                }
                LOCAL_BAR();
                if (!lastl) {
                    ARGS();
                    pg8::Gemm g{(const bf16_t*)(ws + WS_Z), (const bf16_t*)(ws + WS_W + (size_t)l * LW + OW_2), FF, FF, 0, 0, nullptr, nullptr}; pg8::StaticOrder S; S.init(M, D, G, vcu); S.gsel = split ? gs : -1; S.revr = !split;
                    bf16_t* R1 = (bf16_t*)ap->out; bf16_t* R2 = R1 + SEC;
                    EpiResid E{(const void*)R1, (void*)R2, (float*)(ws + WS_SSP) + (size_t)(2 * l + 2) * M * 8, true, false, (LAS float*)(lds + 131072 + 1024)};
                    pg8::gemm_phase<EpiResid>(lds, g, S, E, wave_s);
                } else {
                    ARGS();
                    pg8::Gemm g{(const bf16_t*)(ws + WS_Z), (const bf16_t*)(ws + WS_W + (size_t)l * LW + OW_2), FF, FF, 0, 0, nullptr, nullptr}; pg8::StaticOrder S; S.init(M, D, G, vcu, true); S.gsel = split ? gs : -1; S.revr = !split;
                    EpiFinal E{(const bf16_t*)(ws + WS_H), ap->out, (float*)(ws + WS_SSP) + (size_t)4 * M * 8, ap->in[18], (LAS float*)(lds + 131072 + 1024), xbar, xlocal};
                    pg8::gemm_phase<EpiFinal>(lds, g, S, E, wave_s);
                }
            }
            if (!lastl) LOCAL_BAR();
        }
    }
}

extern "C" void kernel_launch(void* const* d_in, const int* in_sizes, int n_in, void* d_out, int out_size, void* d_ws, size_t ws_size, hipStream_t stream) {
    static int grid = 0;
    if (grid == 0) {
        if (n_in != 19 || out_size != M * D || ws_size < WS_END) { fprintf(stderr, "kernel_launch: unexpected shapes n_in %d out %d ws %zu\n", n_in, out_size, ws_size); grid = -1; return; }
        int dev = 0, cus = 0, per_cu = 0;
        hipGetDevice(&dev); hipDeviceGetAttribute(&cus, hipDeviceAttributeMultiprocessorCount, dev);
        if (hipFuncSetAttribute((const void*)fwd_megakernel, hipFuncAttributeMaxDynamicSharedMemorySize, LDS_BYTES) != hipSuccess) { fprintf(stderr, "kernel_launch: hipFuncSetAttribute failed\n"); grid = -1; return; }
        if (hipOccupancyMaxActiveBlocksPerMultiprocessor(&per_cu, (const void*)fwd_megakernel, 512, LDS_BYTES) != hipSuccess || per_cu < 1) { fprintf(stderr, "kernel_launch: occupancy query says %d\n", per_cu); per_cu = 1; }
        (void)hipGetLastError();
        grid = cus * 1;
    }
    if (grid < 0) return;
    if (hipMemsetAsync(d_ws, 0, 65536, stream) != hipSuccess) { fprintf(stderr, "kernel_launch: memset failed\n"); return; }
    Args a{};
    for (int i = 0; i < 19; ++i) a.in[i] = (const float*)d_in[i];
    a.out = (float*)d_out; a.ws = (unsigned char*)d_ws;
    void* args[] = {&a};
    hipError_t e = hipLaunchCooperativeKernel((const void*)fwd_megakernel, dim3(grid), dim3(512), args, LDS_BYTES, stream);
    if (e != hipSuccess) fprintf(stderr, "cooperative launch failed: %s (grid %d)\n", hipGetErrorString(e), grid);
}
```

```cpp
#include <hip/hip_runtime.h>
#include <hip/hip_cooperative_groups.h>
#include <cstdio>
#include <cstdint>
namespace cg = cooperative_groups;

#define LAS __attribute__((address_space(3)))
typedef unsigned short bf16_t;
typedef short bf16x8 __attribute__((ext_vector_type(8)));
typedef float f32x4 __attribute__((ext_vector_type(4)));
typedef float f32x2 __attribute__((ext_vector_type(2)));
typedef unsigned u32x4 __attribute__((ext_vector_type(4)));
typedef unsigned u32x2 __attribute__((ext_vector_type(2)));

constexpr int M = 16384, D = 2048, NIN = 14336, FF = 8192, SEQ = 4096, DEPTH = 2;
constexpr float EPS = 1e-6f;
constexpr float LOG2E = 1.4426950408889634f;

constexpr size_t MiB = 1u << 20;
constexpr size_t WS_SS = 65536;
constexpr size_t WS_C8 = 1 * MiB;
constexpr size_t WS_W = 2 * MiB, LW = 146 * MiB;
constexpr size_t OW_IN = 0, OW_G = 56 * MiB, OW_PA = 58 * MiB, OW_PB = 66 * MiB, OW_O = 74 * MiB, OW_1 = 82 * MiB, OW_2 = 114 * MiB;
constexpr size_t WS_Z = 296 * MiB;
constexpr size_t SEC = (size_t)M * D;
constexpr size_t WS_H = 744 * MiB;
constexpr size_t WS_B = 808 * MiB;
constexpr size_t WS_AGG = 872 * MiB;
constexpr size_t WS_SSP = 876 * MiB;
constexpr size_t WS_END = 880 * MiB;

constexpr int LDS_BYTES = 147456;
constexpr int REP_P0 = 1, REP_R = 1, REP_G1 = 1, REP_G2 = 1, REP_S1 = 1, REP_G6 = 1, REP_BAR = 1, REP_S3 = 1, REP_CA = 1;

__device__ __forceinline__ unsigned cvt_pk_bf16(float lo, float hi) { unsigned r; asm volatile("v_cvt_pk_bf16_f32 %0, %1, %2" : "=v"(r) : "v"(lo), "v"(hi)); return r; }
__device__ __forceinline__ float bf_lo(unsigned w) { return __uint_as_float(w << 16); }
__device__ __forceinline__ float bf_hi(unsigned w) { return __uint_as_float(w & 0xffff0000u); }
__device__ __forceinline__ float fast_sigmoid(float v) { return __builtin_amdgcn_rcpf(1.0f + __builtin_amdgcn_exp2f(-LOG2E * v)); }
__device__ __forceinline__ float gelu_tanh(float v) {
    const float t = v * (1.0f + 0.044715f * v * v);
    return v * __builtin_amdgcn_rcpf(1.0f + __builtin_amdgcn_exp2f(-2.0f * 0.7978845608028654f * LOG2E * t));
}
__device__ __forceinline__ float rstd_of(const float* ssp, int row) {
    const f32x4 a = *(const f32x4*)(ssp + (size_t)row * 8), b = *(const f32x4*)(ssp + (size_t)row * 8 + 4);
    return rsqrtf((((a.x + a.y) + (a.z + a.w)) + ((b.x + b.y) + (b.z + b.w))) * (1.f / D) + EPS);
}
__device__ __forceinline__ void rstd8(float (&r)[8], const float* ssp, int row0) {
#pragma unroll
    for (int h = 0; h < 2; ++h) {
        f32x4 a[4], b[4];
#pragma unroll
        for (int q = 0; q < 4; ++q) { const size_t o = (size_t)(row0 + h * 128 + q * 16) * 8; a[q] = *(const f32x4*)(ssp + o); b[q] = *(const f32x4*)(ssp + o + 4); }
#pragma unroll
        for (int q = 0; q < 4; ++q) r[h * 4 + q] = rsqrtf((((a[q].x + a[q].y) + (a[q].z + a[q].w)) + ((b[q].x + b[q].y) + (b[q].z + b[q].w))) * (1.f / D) + EPS);
    }
}
__device__ __forceinline__ void rstd8_cached(float (&r)[8], const float* ssp, int tag, int pm, LAS float* rl, int wr, int wc, int fr, int fq) {
    const int cur = ((volatile LAS int*)rl)[0];
    if (cur != tag) {
        asm volatile("s_waitcnt lgkmcnt(0)" ::: "memory"); __builtin_amdgcn_s_barrier(); asm volatile("" ::: "memory");
        const int t = (wr * 4 + wc) * 64 + fq * 16 + fr;
        if (t < 256) { const size_t o = (size_t)(pm * 256 + t) * 8; const f32x4 a = *(const f32x4*)(ssp + o), b = *(const f32x4*)(ssp + o + 4);
            rl[64 + t] = rsqrtf((((a.x + a.y) + (a.z + a.w)) + ((b.x + b.y) + (b.z + b.w))) * (1.f / D) + EPS);
            if (t == 0) ((LAS int*)rl)[0] = tag; }
        asm volatile("s_waitcnt lgkmcnt(0)" ::: "memory"); __builtin_amdgcn_s_barrier(); asm volatile("" ::: "memory");
    }
#pragma unroll
    for (int q = 0; q < 8; ++q) r[q] = rl[64 + (q >> 2) * 128 + wr * 64 + (q & 3) * 16 + fr];
}
__device__ __forceinline__ float wave_sum(float v) {
#pragma unroll
    for (int o = 1; o < 64; o <<= 1) v += __shfl_xor(v, o);
    return v;
}
#define LDS_WAIT() asm volatile("s_waitcnt lgkmcnt(0)" ::: "memory")
__device__ __forceinline__ int lane_id() { int l; asm volatile("v_mbcnt_lo_u32_b32 %0, -1, 0\n\tv_mbcnt_hi_u32_b32 %0, -1, %0" : "=v"(l)); return l; }


#define XB_TMO      128
#define XB_XCNT(j)  (256  + 64 * (j))
#define XB_XSUB(j)  (1280 + 64 * (j))
#define XB_XGEN(j)  (2304 + 64 * (j))
#define XB_TOP      3328
#define XB_TOPGEN   3392
#define XCD_BAR_WORDS 3456
#define XB_SPIN_CAP (1u << 22)
__device__ __forceinline__ unsigned xb_ld(unsigned* p)              { return __hip_atomic_load(p, __ATOMIC_RELAXED, __HIP_MEMORY_SCOPE_AGENT); }
__device__ __forceinline__ unsigned xb_add(unsigned* p, unsigned v) { return __hip_atomic_fetch_add(p, v, __ATOMIC_RELAXED, __HIP_MEMORY_SCOPE_AGENT); }
__device__ __forceinline__ unsigned xb_xcc_id() { return (unsigned)__builtin_amdgcn_s_getreg((3 << 11) | 20) & 0xFu; }
#define XB_SPIN(cond, bar) do { unsigned _sp = 0; while (cond) { __builtin_amdgcn_s_sleep(1); \
    if ((++_sp & 255u) == 0u) { if (xb_ld(&(bar)[XB_TMO])) break; if (_sp > XB_SPIN_CAP) { atomicAdd(&(bar)[XB_TMO], 1u); break; } } } } while (0)
struct XcdBarrier { unsigned* bar; unsigned x; volatile LAS unsigned* st; int wave; };
__device__ __forceinline__ XcdBarrier xcd_barrier_post(unsigned* bar, volatile LAS unsigned* st) {
    XcdBarrier b; b.bar = bar; b.x = xb_xcc_id(); b.st = st; b.wave = 0;
    return b;
}
__device__ __forceinline__ void xcd_barrier_complete(unsigned* bar, unsigned x, unsigned& nloc, unsigned& nx) {
    const unsigned G = gridDim.x * gridDim.y * gridDim.z;
    unsigned sum, cnt, mine, sp = 0u;
    for (;;) {
        sum = 0u; cnt = 0u; mine = 0u;
#pragma unroll
        for (unsigned j = 0; j < 16; ++j) { const unsigned c = xb_ld(&bar[XB_XCNT(j)]); sum += c; cnt += (c > 0u) ? 1u : 0u; mine = (j == x) ? c : mine; }
        if (sum == G) break;
        __builtin_amdgcn_s_sleep(1);
        if ((++sp & 255u) == 0u) { if (xb_ld(&bar[XB_TMO])) break; if (sp > XB_SPIN_CAP) { atomicAdd(&bar[XB_TMO], 1u); break; } }
    }
    nloc = mine > 0u ? mine : 1u; nx = cnt > 0u ? cnt : 1u;
}
__device__ __forceinline__ void xcd_barrier(const XcdBarrier& b) {
    asm volatile("s_waitcnt vmcnt(0)" ::: "memory");
    __syncthreads();
    if (b.wave == 0 && lane_id() == 0) {
        unsigned* bar = b.bar;
        __builtin_amdgcn_s_waitcnt(0);
        unsigned nloc = b.st[0], nx = b.st[1];
        if (nloc == 0u) { xcd_barrier_complete(bar, b.x, nloc, nx); b.st[0] = nloc; b.st[1] = nx; }
        const unsigned old = xb_add(&bar[XB_XSUB(b.x)], 1u);
        const unsigned gen = old / nloc;
        if (old + 1u == (gen + 1u) * nloc) {
            __builtin_amdgcn_fence(__ATOMIC_RELEASE, "agent");
            asm volatile("s_waitcnt vmcnt(0)" ::: "memory");
            const unsigned og = xb_add(&bar[XB_TOP], 1u);
            const unsigned tg = og / nx;
            if (og + 1u == (tg + 1u) * nx) xb_add(&bar[XB_TOPGEN], 1u);
            else XB_SPIN(xb_ld(&bar[XB_TOPGEN]) == tg, bar);
            __builtin_amdgcn_fence(__ATOMIC_ACQUIRE, "agent");
            xb_add(&bar[XB_XGEN(b.x)], 1u);
            asm volatile("s_waitcnt vmcnt(0)" ::: "memory");
        } else {
            XB_SPIN(xb_ld(&bar[XB_XGEN(b.x)]) == gen, bar);
            __builtin_amdgcn_fence(__ATOMIC_ACQUIRE, "agent");
            asm volatile("s_waitcnt vmcnt(0)" ::: "memory");
        }
    }
    __syncthreads();
}

#define XB_LSUB(j)  (4096 + 64 * (j))
#define XB_LGEN(j)  (5120 + 64 * (j))
__device__ __forceinline__ void xcd_local_barrier(const XcdBarrier& b) {
    asm volatile("s_waitcnt vmcnt(0)" ::: "memory");
    __syncthreads();
    if (b.wave == 0 && lane_id() == 0) {
        unsigned* bar = b.bar;
        __builtin_amdgcn_s_waitcnt(0);
        const unsigned nloc = b.st[0];
        const unsigned old = xb_add(&bar[XB_LSUB(b.x)], 1u);
        const unsigned gen = old / nloc;
        if (old + 1u == (gen + 1u) * nloc) xb_add(&bar[XB_LGEN(b.x)], 1u);
        else XB_SPIN(xb_ld(&bar[XB_LGEN(b.x)]) == gen, bar);
        __builtin_amdgcn_fence(__ATOMIC_ACQUIRE, "agent");
        asm volatile("s_waitcnt vmcnt(0)" ::: "memory");
    }
    __syncthreads();
}

namespace pg8 {
constexpr int BM = 256, BK = 64, HALF = 128, HTB = HALF * BK * 2, STAGE_BYTES = 8 * HTB, NXCD = 8, WGM = 4;
__host__ __device__ __forceinline__ int lds_byte(int r, int c) { const int st = (r >> 4) * 2 + (c >> 5), rr = r & 15, cc = c & 31, ob = rr * 64 + cc * 2; return st * 1024 + (ob ^ (((ob >> 9) & 1) << 5)); }
__host__ __device__ __forceinline__ void stage_rc(int b, int& R, int& C) { const int st = b / 1024, sb = b % 1024, swz = sb ^ (((sb >> 9) & 1) << 5); R = (st >> 1) * 16 + swz / 64; C = (st & 1) * 32 + (swz % 64) / 2; }
__host__ __device__ __forceinline__ int perm32(int rho) { const int n = rho >> 4, i = rho & 15; return 8 * (i >> 2) + 4 * n + (i & 3); }

struct Unit { int pm, pn; };
struct Gemm { const bf16_t* A; const bf16_t* Bt; int lda, K, ash, amul; const bf16_t* A2; const bf16_t* Bt2; };

struct StaticOrder {
    int nM, nN, nwg, G, c; bool revr; bool pmajor;
    __device__ void init(int M_, int N_, int G_, int c_, bool pmajor_ = false) { nM = M_ / BM; nN = N_ / BM; nwg = nM * nN; G = G_; c = c_; pmajor = pmajor_; revr = false; }
    __device__ bool next(int i, Unit& u) const {
        if ((long)i * G + c >= nwg) return false;
        const int nR = nwg / G; const int ii = (revr && nwg % G == 0) ? (nR - 1 - i) : i;
        const long L = (long)ii * G + c;
        int wgid = (int)L; { const int q = nwg / NXCD, r = nwg % NXCD, xcd = wgid % NXCD, off = wgid / NXCD; wgid = (xcd < r ? xcd * (q + 1) : r * (q + 1) + (xcd - r) * q) + off; }
        const int nig = WGM * nN, gid = wgid / nig, fm = gid * WGM, gsz = (nM - fm) < WGM ? (nM - fm) : WGM;
        const int w = wgid % nig;
        if (pmajor) { u.pn = w % nN; u.pm = fm + w / nN; } else { u.pm = fm + (w % gsz); u.pn = w / gsz; }
        return true;
    }
};

template <class Epi, int NSEG = 1>
__device__ __forceinline__ void gemm_phase(LAS unsigned char* lds, const Gemm g, const StaticOrder& S, const Epi& E, int wave_s) {
    int tid = wave_s * 64 + lane_id(); asm volatile("" : "+v"(tid));
    const int wid = __builtin_amdgcn_readfirstlane(tid >> 6), lane = tid & 63, wr = wid >> 2, wc = wid & 3, fr = lane & 15, fq = lane >> 4;
    const int K = g.K, nt = K / BK, lda = g.lda;
    unsigned voffA[2], voffB[2];
#pragma unroll
    for (int i = 0; i < 2; ++i) { int R, C; stage_rc(tid * 16 + i * 8192, R, C); const int Rb = Epi::PERM ? ((R & ~31) + perm32(R & 31)) : R;
        voffA[i] = (unsigned)(R * lda + C) * 2u; voffB[i] = (unsigned)(Rb * K + C) * 2u; }
    const size_t kstep = (size_t)(BK * 2);
    const size_t hstepA = (size_t)HALF * lda * 2, hstepB = (size_t)HALF * K * 2;
    const size_t tstepA = 2 * hstepA, tstepB = 2 * hstepB;
    const unsigned ldsw = (unsigned)wid * 1024u;
    const int aoff = lds_byte(wr * 64 + fr, fq * 8), boff = lds_byte(wc * 32 + fr, fq * 8);
#define PG8_SA(b, h) (((b) * 2 + (h)) * HTB)
#define PG8_SB(b, h) ((4 + (b) * 2 + (h)) * HTB)
#define PG8_STAGE(bufoff, gbase, voff) do { _Pragma("unroll") for (int _i = 0; _i < 2; ++_i) \
        __builtin_amdgcn_global_load_lds((const unsigned*)((const char*)(gbase) + (voff)[_i]), (LAS unsigned*)(lds + (bufoff) + ldsw + _i * 8192), 16, 0, 0); } while (0)
#define PG8_LDA(dst, b, h) do { _Pragma("unroll") for (int m = 0; m < 4; ++m) _Pragma("unroll") for (int k = 0; k < 2; ++k) dst[m][k] = *(const LAS bf16x8*)(lds + PG8_SA(b, h) + aoff + m * 2048 + k * 1024); } while (0)
#define PG8_LDB(dst, b, h) do { _Pragma("unroll") for (int n = 0; n < 2; ++n) _Pragma("unroll") for (int k = 0; k < 2; ++k) dst[n][k] = *(const LAS bf16x8*)(lds + PG8_SB(b, h) + boff + n * 2048 + k * 1024); } while (0)
#define PG8_MMA(ai, bj, At, Bt) do { __builtin_amdgcn_s_setprio(1); _Pragma("unroll") for (int m = 0; m < 4; ++m) _Pragma("unroll") for (int n = 0; n < 2; ++n) _Pragma("unroll") for (int k = 0; k < 2; ++k) \
        acc[ai][bj][m][n] = __builtin_amdgcn_mfma_f32_16x16x32_bf16(Bt[n][k], At[m][k], acc[ai][bj][m][n], 0, 0, 0); __builtin_amdgcn_s_setprio(0); } while (0)
#define PG8_WAIT_V(n) asm volatile("s_waitcnt vmcnt(" #n ")" ::: "memory")
#define PG8_WAIT_L(n) asm volatile("s_waitcnt lgkmcnt(" #n ")" ::: "memory")
#define PG8_BAR __builtin_amdgcn_s_barrier()
#define PG8_SCHED __builtin_amdgcn_sched_barrier(0)
    Unit cur, nxt; int ui = 0;
    if (!S.next(0, cur)) return;
    f32x4 acc[2][2][4][2];
#pragma unroll
    for (int a = 0; a < 2; ++a)
#pragma unroll
        for (int b = 0; b < 2; ++b)
#pragma unroll
            for (int m = 0; m < 4; ++m)
#pragma unroll
                for (int n = 0; n < 2; ++n) acc[a][b][m][n] = (f32x4){0.f, 0.f, 0.f, 0.f};
    bf16x8 At[4][2], B0[2][2], B1[2][2];
    const char* cA = (const char*)g.A + (size_t)cur.pm * tstepA + (size_t)((cur.pn >> g.ash) * g.amul) * 2; const char* cB = (const char*)g.Bt + (size_t)cur.pn * tstepB;
    PG8_STAGE(PG8_SB(0, 0), cB, voffB); PG8_STAGE(PG8_SB(0, 1), cB + hstepB, voffB); PG8_STAGE(PG8_SA(0, 0), cA, voffA); PG8_STAGE(PG8_SA(0, 1), cA + hstepA, voffA);
    if (wr == 1) PG8_BAR;
    PG8_WAIT_V(2); PG8_BAR;
    PG8_STAGE(PG8_SB(1, 0), cB + kstep, voffB); PG8_STAGE(PG8_SA(1, 0), cA + kstep, voffA); PG8_STAGE(PG8_SB(1, 1), cB + hstepB + kstep, voffB);
    PG8_WAIT_V(6); PG8_BAR;
#define PG8_KLOOP() do { \
        _Pragma("unroll 1") \
        for (int t = 0; t < nt; t += 2) { \
            const bool last = (t == nt - 2); \
            const char* a1 = cA + (size_t)(t + 1) * kstep; \
            const char* a2 = last ? nA : cA + (size_t)(t + 2) * kstep; const char* b2 = last ? nB : cB + (size_t)(t + 2) * kstep; \
            const char* a3 = a2 + kstep; const char* b3 = b2 + kstep; \
            PG8_LDB(B0, 0, 0); PG8_LDB(B1, 0, 1); PG8_SCHED; PG8_LDA(At, 0, 0); PG8_STAGE(PG8_SA(1, 1), a1 + hstepA, voffA); \
            PG8_WAIT_V(8); PG8_WAIT_L(0); PG8_BAR; PG8_MMA(0, 0, At, B0); PG8_MMA(0, 1, At, B1); PG8_BAR; PG8_SCHED; \
            PG8_LDA(At, 0, 1); PG8_STAGE(PG8_SB(0, 0), b2, voffB); PG8_STAGE(PG8_SB(0, 1), b2 + hstepB, voffB); PG8_STAGE(PG8_SA(0, 0), a2, voffA); \
            PG8_WAIT_V(8); PG8_WAIT_L(0); PG8_BAR; PG8_MMA(1, 0, At, B0); PG8_MMA(1, 1, At, B1); PG8_BAR; PG8_SCHED; \
            PG8_LDB(B0, 1, 0); PG8_LDB(B1, 1, 1); PG8_SCHED; PG8_LDA(At, 1, 0); PG8_STAGE(PG8_SA(0, 1), a2 + hstepA, voffA); \
            PG8_WAIT_V(8); PG8_WAIT_L(0); PG8_BAR; PG8_MMA(0, 0, At, B0); PG8_MMA(0, 1, At, B1); PG8_BAR; PG8_SCHED; \
            PG8_LDA(At, 1, 1); PG8_STAGE(PG8_SB(1, 0), b3, voffB); PG8_STAGE(PG8_SB(1, 1), b3 + hstepB, voffB); PG8_STAGE(PG8_SA(1, 0), a3, voffA); \
            PG8_WAIT_V(8); PG8_WAIT_L(0); PG8_BAR; PG8_MMA(1, 0, At, B0); PG8_MMA(1, 1, At, B1); PG8_BAR; PG8_SCHED; \
        } \
    } while (0)
    for (;;) {
        if constexpr (NSEG > 1) {
            const char* nA = (const char*)g.A2 + (size_t)cur.pm * tstepA + (size_t)((cur.pn >> g.ash) * g.amul) * 2; const char* nB = (const char*)g.Bt2 + (size_t)cur.pn * tstepB;
            PG8_KLOOP();
            if (wr == 0) PG8_BAR;
            E.mid(acc, cur, wr, wc, fr, fq);
            cA = nA; cB = nB;
            if (wr == 1) PG8_BAR;
        }
        const bool has_next = S.next(ui + 1, nxt);
        const char* nA = has_next ? (const char*)g.A + (size_t)nxt.pm * tstepA + (size_t)((nxt.pn >> g.ash) * g.amul) * 2 : cA; const char* nB = has_next ? (const char*)g.Bt + (size_t)nxt.pn * tstepB : cB;
        PG8_KLOOP();
        if (wr == 0) PG8_BAR;
        E(acc, cur, wr, wc, fr, fq);
        if (!has_next) break;
#pragma unroll
        for (int a = 0; a < 2; ++a)
#pragma unroll
            for (int b = 0; b < 2; ++b)
#pragma unroll
                for (int m = 0; m < 4; ++m)
#pragma unroll
                    for (int n = 0; n < 2; ++n) acc[a][b][m][n] = (f32x4){0.f, 0.f, 0.f, 0.f};
        cur = nxt; cA = nA; cB = nB; ++ui;
        if (wr == 1) PG8_BAR;
    }
    PG8_WAIT_V(0);
    PG8_BAR;
#undef PG8_KLOOP
#undef PG8_SA
#undef PG8_SB
#undef PG8_STAGE
#undef PG8_LDA
#undef PG8_LDB
#undef PG8_MMA
#undef PG8_WAIT_V
#undef PG8_WAIT_L
#undef PG8_BAR
#undef PG8_SCHED
}
}
using pg8::Unit;

typedef f32x4 AccT[2][2][4][2];

struct EpiIn {
    static constexpr bool PERM = true;
    bf16_t* Z; const float* bias; const float* ss; int stage; LAS float* rl;
    __device__ __forceinline__ void operator()(const AccT& acc, const Unit& u, int wr, int wc, int fr, int fq) const {
        const int row0 = u.pm * 256 + wr * 64 + fr;
        float rs[8]; rstd8_cached(rs, ss, (stage << 8) | u.pm, u.pm, rl, wr, wc, fr, fq);
        if (u.pn >= 24 && u.pn < 40) {
            const int ch0 = (u.pn - 24) * 128 + wc * 32 + 8 * fq;
            f32x4 bc[2], bx[2];
#pragma unroll
            for (int n = 0; n < 2; ++n) { bc[n] = *(const f32x4*)(bias + 3 * D + ch0 + 4 * n); bx[n] = *(const f32x4*)(bias + 4 * D + ch0 + 4 * n); }
            bf16_t* base = Z + 3 * SEC;
#pragma unroll
            for (int ai = 0; ai < 2; ++ai)
#pragma unroll
                for (int m = 0; m < 4; ++m) { const int row = row0 + ai * 128 + m * 16;
                    const float rstd = rs[ai * 4 + m];
                    const f32x4 v0 = (acc[ai][0][m][0] * rstd + bc[0]) * (acc[ai][1][m][0] * rstd + bx[0]), v1 = (acc[ai][0][m][1] * rstd + bc[1]) * (acc[ai][1][m][1] * rstd + bx[1]);
                    u32x4 w; w.x = cvt_pk_bf16(v0[0], v0[1]); w.y = cvt_pk_bf16(v0[2], v0[3]); w.z = cvt_pk_bf16(v1[0], v1[1]); w.w = cvt_pk_bf16(v1[2], v1[3]);
                    *(u32x4*)(base + (size_t)row * D + ch0) = w; }
            return;
        }
        if (u.pn >= 40) {
            const int ch0 = (u.pn - 40) * 128 + wc * 32 + 8 * fq;
            f32x4 ba[2], bb[2];
#pragma unroll
            for (int n = 0; n < 2; ++n) { ba[n] = *(const f32x4*)(bias + 5 * D + ch0 + 4 * n); bb[n] = *(const f32x4*)(bias + 6 * D + ch0 + 4 * n); }
#pragma unroll
            for (int ai = 0; ai < 2; ++ai)
#pragma unroll
                for (int m = 0; m < 4; ++m) { const int row = row0 + ai * 128 + m * 16;
                    const float rstd = rs[ai * 4 + m];
                    f32x4 rt[2], sb[2];
#pragma unroll
                    for (int n = 0; n < 2; ++n)
#pragma unroll
                        for (int j = 0; j < 4; ++j) { const float ea = __builtin_amdgcn_exp2f(-LOG2E * (acc[ai][0][m][n][j] * rstd + ba[n][j])), eb = __builtin_amdgcn_exp2f(-LOG2E * (acc[ai][1][m][n][j] * rstd + bb[n][j]));
                            sb[n][j] = __builtin_amdgcn_rcpf(1.0f + eb); rt[n][j] = (1.0f + eb) * __builtin_amdgcn_rcpf(1.0f + ea); }
                    u32x4 w; w.x = cvt_pk_bf16(rt[0][0], rt[0][1]); w.y = cvt_pk_bf16(rt[0][2], rt[0][3]); w.z = cvt_pk_bf16(rt[1][0], rt[1][1]); w.w = cvt_pk_bf16(rt[1][2], rt[1][3]);
                    *(u32x4*)(Z + 5 * SEC + (size_t)row * D + ch0) = w;
                    u32x4 v; v.x = cvt_pk_bf16(sb[0][0], sb[0][1]); v.y = cvt_pk_bf16(sb[0][2], sb[0][3]); v.z = cvt_pk_bf16(sb[1][0], sb[1][1]); v.w = cvt_pk_bf16(sb[1][2], sb[1][3]);
                    *(u32x4*)(Z + 6 * SEC + (size_t)row * D + ch0) = v; }
            return;
        }
        const int s = u.pn >> 3; const int colt = (u.pn & 7) * 256;
        bf16_t* base = Z + (size_t)s * SEC;
        const int col0 = colt + wc * 32 + 8 * fq, bcol0 = s * D + col0;
        f32x4 bv[2][2];
#pragma unroll
        for (int bj = 0; bj < 2; ++bj)
#pragma unroll
            for (int n = 0; n < 2; ++n) bv[bj][n] = *(const f32x4*)(bias + bcol0 + bj * 128 + 4 * n);
#pragma unroll
        for (int ai = 0; ai < 2; ++ai)
#pragma unroll
            for (int m = 0; m < 4; ++m) { bf16_t* rowp = base + (size_t)(row0 + ai * 128 + m * 16) * D + col0;
                const float rstd = rs[ai * 4 + m];
#pragma unroll
                for (int bj = 0; bj < 2; ++bj) { f32x4 v0 = acc[ai][bj][m][0] * rstd + bv[bj][0], v1 = acc[ai][bj][m][1] * rstd + bv[bj][1];
                    u32x4 w; w.x = cvt_pk_bf16(v0[0], v0[1]); w.y = cvt_pk_bf16(v0[2], v0[3]); w.z = cvt_pk_bf16(v1[0], v1[1]); w.w = cvt_pk_bf16(v1[2], v1[3]);
                    *(u32x4*)(rowp + bj * 128) = w; } }
    }
};

struct EpiGate {
    static constexpr bool PERM = true;
    const bf16_t* XC; bf16_t* LA; bf16_t* BV; const float* br; const float* bi; const float* c8p;
    __device__ __forceinline__ void operator()(const AccT& acc, const Unit& u, int wr, int wc, int fr, int fq) const {
        const int row0 = u.pm * 256 + wr * 64 + fr, ch0 = u.pn * 128 + wc * 32 + 8 * fq;
        f32x4 brv[2], biv[2], c8[2];
#pragma unroll
        for (int n = 0; n < 2; ++n) { brv[n] = *(const f32x4*)(br + ch0 + 4 * n); biv[n] = *(const f32x4*)(bi + ch0 + 4 * n); c8[n] = *(const f32x4*)(c8p + ch0 + 4 * n); }
        u32x4 xw4[8];
#pragma unroll
        for (int q = 0; q < 8; ++q) xw4[q] = *(const u32x4*)(XC + (size_t)(row0 + (q >> 2) * 128 + (q & 3) * 16) * D + ch0);
#pragma unroll
        for (int ai = 0; ai < 2; ++ai)
#pragma unroll
            for (int m = 0; m < 4; ++m) { const size_t off = (size_t)(row0 + ai * 128 + m * 16) * D + ch0;
                const u32x4 xq = xw4[ai * 4 + m];
                const float xv[8] = {bf_lo(xq.x), bf_hi(xq.x), bf_lo(xq.y), bf_hi(xq.y), bf_lo(xq.z), bf_hi(xq.z), bf_lo(xq.w), bf_hi(xq.w)};
                float lo[8], bo[8];
#pragma unroll
                for (int n = 0; n < 2; ++n)
#pragma unroll
                    for (int j = 0; j < 4; ++j) { const float r = fast_sigmoid(acc[ai][0][m][n][j] + brv[n][j]), ig = fast_sigmoid(acc[ai][1][m][n][j] + biv[n][j]);
                        const float la = c8[n][j] * r; const float a2 = __builtin_amdgcn_exp2f(2.0f * la);
                        const float mult = __builtin_amdgcn_sqrtf(fmaxf(1.0f - a2, 0.0f));
                        lo[n * 4 + j] = la; bo[n * 4 + j] = mult * ig * xv[n * 4 + j]; }
                u32x4 w; w.x = cvt_pk_bf16(lo[0], lo[1]); w.y = cvt_pk_bf16(lo[2], lo[3]); w.z = cvt_pk_bf16(lo[4], lo[5]); w.w = cvt_pk_bf16(lo[6], lo[7]);
                *(u32x4*)(LA + off) = w;
                u32x4 v; v.x = cvt_pk_bf16(bo[0], bo[1]); v.y = cvt_pk_bf16(bo[2], bo[3]); v.z = cvt_pk_bf16(bo[4], bo[5]); v.w = cvt_pk_bf16(bo[6], bo[7]);
                *(u32x4*)(BV + off) = v; }
    }
};

struct EpiMerge2 {
    static constexpr bool PERM = true;
    bf16_t* RT; const bf16_t* GB;
    __device__ __forceinline__ void mid(AccT& acc, const Unit& u, int wr, int wc, int fr, int fq) const {
        const int row0 = u.pm * 256 + wr * 64 + fr, col0 = u.pn * 256 + wc * 32 + 8 * fq;
#pragma unroll
        for (int q = 0; q < 4; ++q) { const int ai = q >> 1, m0 = (q & 1) * 2;
            u32x4 rw[2][2];
#pragma unroll
            for (int mm = 0; mm < 2; ++mm)
#pragma unroll
                for (int bj = 0; bj < 2; ++bj) rw[mm][bj] = *(const u32x4*)(RT + (size_t)(row0 + ai * 128 + (m0 + mm) * 16) * D + col0 + bj * 128);
#pragma unroll
            for (int mm = 0; mm < 2; ++mm)
#pragma unroll
                for (int bj = 0; bj < 2; ++bj) { const u32x4 r = rw[mm][bj]; const int m = m0 + mm;
                    acc[ai][bj][m][0] *= (f32x4){bf_lo(r.x), bf_hi(r.x), bf_lo(r.y), bf_hi(r.y)}; acc[ai][bj][m][1] *= (f32x4){bf_lo(r.z), bf_hi(r.z), bf_lo(r.w), bf_hi(r.w)}; }
            asm volatile("" ::: "memory"); __builtin_amdgcn_sched_barrier(0);
        }
    }
    __device__ __forceinline__ void operator()(const AccT& acc, const Unit& u, int wr, int wc, int fr, int fq) const {
        const int row0 = u.pm * 256 + wr * 64 + fr, col0 = u.pn * 256 + wc * 32 + 8 * fq;
#pragma unroll
        for (int ai = 0; ai < 2; ++ai) {
            u32x4 gb[4][2];
#pragma unroll
            for (int m = 0; m < 4; ++m)
#pragma unroll
                for (int bj = 0; bj < 2; ++bj) gb[m][bj] = __builtin_nontemporal_load((const u32x4*)(GB + (size_t)(row0 + ai * 128 + m * 16) * D + col0 + bj * 128));
#pragma unroll
            for (int m = 0; m < 4; ++m)
#pragma unroll
                for (int bj = 0; bj < 2; ++bj) { const u32x4 b = gb[m][bj];
                    const f32x4 v0 = acc[ai][bj][m][0] * (f32x4){bf_lo(b.x), bf_hi(b.x), bf_lo(b.y), bf_hi(b.y)}, v1 = acc[ai][bj][m][1] * (f32x4){bf_lo(b.z), bf_hi(b.z), bf_lo(b.w), bf_hi(b.w)};
                    u32x4 w; w.x = cvt_pk_bf16(v0[0], v0[1]); w.y = cvt_pk_bf16(v0[2], v0[3]); w.z = cvt_pk_bf16(v1[0], v1[1]); w.w = cvt_pk_bf16(v1[2], v1[3]);
                    *(u32x4*)(RT + (size_t)(row0 + ai * 128 + m * 16) * D + col0 + bj * 128) = w; }
        }
    }
};

struct EpiResid {
    static constexpr bool PERM = true;
    const void* base; void* out; float* ss; bool base_bf16, out_f32; LAS float* red;
    __device__ __forceinline__ void operator()(const AccT& acc, const Unit& u, int wr, int wc, int fr, int fq) const {
        const int row0 = u.pm * 256 + wr * 64 + fr, col0 = u.pn * 256 + wc * 32 + 8 * fq;
#pragma unroll
        for (int ai = 0; ai < 2; ++ai) {
            f32x4 bs[4][2][2];
            if (base_bf16) {
                const bf16_t* bp = (const bf16_t*)base;
                u32x4 raw[4][2];
#pragma unroll
                for (int m = 0; m < 4; ++m)
#pragma unroll
                    for (int bj = 0; bj < 2; ++bj) raw[m][bj] = *(const u32x4*)(bp + (size_t)(row0 + ai * 128 + m * 16) * D + col0 + bj * 128);
#pragma unroll
                for (int m = 0; m < 4; ++m)
#pragma unroll
                    for (int bj = 0; bj < 2; ++bj) { const u32x4 r = raw[m][bj]; bs[m][bj][0] = (f32x4){bf_lo(r.x), bf_hi(r.x), bf_lo(r.y), bf_hi(r.y)}; bs[m][bj][1] = (f32x4){bf_lo(r.z), bf_hi(r.z), bf_lo(r.w), bf_hi(r.w)}; }
            } else {
                const float* bp = (const float*)base;
#pragma unroll
                for (int m = 0; m < 4; ++m)
#pragma unroll
                    for (int bj = 0; bj < 2; ++bj) { const size_t off = (size_t)(row0 + ai * 128 + m * 16) * D + col0 + bj * 128; bs[m][bj][0] = *(const f32x4*)(bp + off); bs[m][bj][1] = *(const f32x4*)(bp + off + 4); }
            }
#pragma unroll
            for (int m = 0; m < 4; ++m) { const int row = row0 + ai * 128 + m * 16; const size_t off = (size_t)row * D + col0; float sq = 0.f;
#pragma unroll
                for (int bj = 0; bj < 2; ++bj) {
                    const f32x4 v0 = bs[m][bj][0] + acc[ai][bj][m][0], v1 = bs[m][bj][1] + acc[ai][bj][m][1];
                    sq += (v0[0] * v0[0] + v0[1] * v0[1]) + (v0[2] * v0[2] + v0[3] * v0[3]) + (v1[0] * v1[0] + v1[1] * v1[1]) + (v1[2] * v1[2] + v1[3] * v1[3]);
                    if (out_f32) { float* op = (float*)out; *(f32x4*)(op + off + bj * 128) = v0; *(f32x4*)(op + off + bj * 128 + 4) = v1; }
                    else { u32x4 w; w.x = cvt_pk_bf16(v0[0], v0[1]); w.y = cvt_pk_bf16(v0[2], v0[3]); w.z = cvt_pk_bf16(v1[0], v1[1]); w.w = cvt_pk_bf16(v1[2], v1[3]);
                        *(u32x4*)((bf16_t*)out + off + bj * 128) = w; } }
                sq += __shfl_xor(sq, 16); sq += __shfl_xor(sq, 32);
                if (fq == 0) red[(ai * 128 + wr * 64 + m * 16 + fr) * 4 + wc] = sq; }
            asm volatile("" ::: "memory"); }
        asm volatile("s_waitcnt lgkmcnt(0)" ::: "memory"); __builtin_amdgcn_s_barrier(); asm volatile("" ::: "memory");
        { const int t = (wr * 4 + wc) * 64 + fq * 16 + fr; if (t < 256) { const f32x4 p = *(const LAS f32x4*)(red + t * 4); ss[(size_t)(u.pm * 256 + t) * 8 + u.pn] = (p.x + p.y) + (p.z + p.w); } }
    }
};

struct EpiFinal {
    static constexpr bool PERM = true;
    const bf16_t* base; float* out; float* ssp; const float* gain; LAS float* red; XcdBarrier xb; bool xlocal;
    __device__ __forceinline__ void operator()(AccT& acc, const Unit& u, int wr, int wc, int fr, int fq) const {
        const int row0 = u.pm * 256 + wr * 64 + fr, col0 = u.pn * 256 + wc * 32 + 8 * fq;
#pragma unroll
        for (int ai = 0; ai < 2; ++ai) {
            u32x4 raw[4][2];
#pragma unroll
            for (int m = 0; m < 4; ++m)
#pragma unroll
                for (int bj = 0; bj < 2; ++bj) raw[m][bj] = *(const u32x4*)(base + (size_t)(row0 + ai * 128 + m * 16) * D + col0 + bj * 128);
#pragma unroll
            for (int m = 0; m < 4; ++m) { float sq = 0.f;
#pragma unroll
                for (int bj = 0; bj < 2; ++bj) { const u32x4 r = raw[m][bj];
                    const f32x4 v0 = (f32x4){bf_lo(r.x), bf_hi(r.x), bf_lo(r.y), bf_hi(r.y)} + acc[ai][bj][m][0], v1 = (f32x4){bf_lo(r.z), bf_hi(r.z), bf_lo(r.w), bf_hi(r.w)} + acc[ai][bj][m][1];
                    acc[ai][bj][m][0] = v0; acc[ai][bj][m][1] = v1;
                    sq += (v0[0] * v0[0] + v0[1] * v0[1]) + (v0[2] * v0[2] + v0[3] * v0[3]) + (v1[0] * v1[0] + v1[1] * v1[1]) + (v1[2] * v1[2] + v1[3] * v1[3]); }
                sq += __shfl_xor(sq, 16); sq += __shfl_xor(sq, 32);
                if (fq == 0) red[(ai * 128 + wr * 64 + m * 16 + fr) * 4 + wc] = sq; }
        }
        asm volatile("s_waitcnt lgkmcnt(0)" ::: "memory"); __builtin_amdgcn_s_barrier(); asm volatile("" ::: "memory");
        { const int t = (wr * 4 + wc) * 64 + fq * 16 + fr; if (t < 256) { const f32x4 p = *(const LAS f32x4*)(red + t * 4); ssp[(size_t)(u.pm * 256 + t) * 8 + u.pn] = (p.x + p.y) + (p.z + p.w); } }
        if (xlocal) xcd_local_barrier(xb); else xcd_barrier(xb);
        f32x4 gv[2][2];
#pragma unroll
        for (int bj = 0; bj < 2; ++bj) { gv[bj][0] = *(const f32x4*)(gain + col0 + bj * 128); gv[bj][1] = *(const f32x4*)(gain + col0 + bj * 128 + 4); }
        float rs[8]; rstd8(rs, ssp, row0);
#pragma unroll
        for (int ai = 0; ai < 2; ++ai)
#pragma unroll
            for (int m = 0; m < 4; ++m) { const int row = row0 + ai * 128 + m * 16; const float rstd = rs[ai * 4 + m];
#pragma unroll
                for (int bj = 0; bj < 2; ++bj) { float* op = out + (size_t)row * D + col0 + bj * 128;
                    *(f32x4*)op = acc[ai][bj][m][0] * rstd * gv[bj][0]; *(f32x4*)(op + 4) = acc[ai][bj][m][1] * rstd * gv[bj][1]; } }
    }
};

struct EpiRelu2 {
    static constexpr bool PERM = true;
    bf16_t* U; const float* ss; int stage; LAS float* rl;
    __device__ __forceinline__ void operator()(const AccT& acc, const Unit& u, int wr, int wc, int fr, int fq) const {
        const int row0 = u.pm * 256 + wr * 64 + fr, col0 = u.pn * 256 + wc * 32 + 8 * fq;
        float rs[8]; rstd8_cached(rs, ss, (stage << 8) | u.pm, u.pm, rl, wr, wc, fr, fq);
#pragma unroll
        for (int ai = 0; ai < 2; ++ai)
#pragma unroll
            for (int m = 0; m < 4; ++m) { bf16_t* rowp = U + (size_t)(row0 + ai * 128 + m * 16) * FF + col0;
                const float rstd = rs[ai * 4 + m];
#pragma unroll
                for (int bj = 0; bj < 2; ++bj) { f32x4 v0 = acc[ai][bj][m][0], v1 = acc[ai][bj][m][1];
#pragma unroll
                    for (int j = 0; j < 4; ++j) { const float a = fmaxf(v0[j], 0.f) * rstd, b = fmaxf(v1[j], 0.f) * rstd; v0[j] = a * a; v1[j] = b * b; }
                    u32x4 w; w.x = cvt_pk_bf16(v0[0], v0[1]); w.y = cvt_pk_bf16(v0[2], v0[3]); w.z = cvt_pk_bf16(v1[0], v1[1]); w.w = cvt_pk_bf16(v1[2], v1[3]);
                    *(u32x4*)(rowp + bj * 128) = w; } }
    }
};

struct TItem { const float* src; bf16_t* dst; const float* gs; int N, K; };
constexpr int I_IN = (D / 64) * (NIN / 32), I_G = 2 * 8 * (256 / 64) * (256 / 32), I_P = (D / 64) * (D / 32), I_1 = (D / 64) * (FF / 32), I_2 = (FF / 64) * (D / 32);
constexpr int PER_LAYER = I_IN + I_G + 3 * I_P + I_1 + I_2;

struct Args { const float* in[19]; float* out; unsigned char* ws; };
typedef __attribute__((address_space(4))) Args KArgs;

__device__ __forceinline__ void rms_phase(const float* x, const float* g, bf16_t* out, int gw, int NGW, int lane) {
    for (int m = gw; m < M; m += NGW) {
        const f32x4* xr = (const f32x4*)(x + (size_t)m * D) + lane;
        f32x4 v[8]; float s = 0.f;
#pragma unroll
        for (int j = 0; j < 8; ++j) { v[j] = xr[64 * j]; s += (v[j].x * v[j].x + v[j].y * v[j].y) + (v[j].z * v[j].z + v[j].w * v[j].w); }
        const float rstd = rsqrtf(wave_sum(s) * (1.f / D) + EPS);
        u32x2* o = (u32x2*)(out + (size_t)m * D) + lane;
#pragma unroll
        for (int j = 0; j < 8; ++j) { const f32x4 gv = ((const f32x4*)g)[lane + 64 * j]; const f32x4 y = v[j] * rstd * gv; u32x2 w; w.x = cvt_pk_bf16(y.x, y.y); w.y = cvt_pk_bf16(y.z, y.w); o[64 * j] = w; }
    }
}
#define UNPK8(dst, p) do { dst[0] = bf_lo(p.x); dst[1] = bf_hi(p.x); dst[2] = bf_lo(p.y); dst[3] = bf_hi(p.y); dst[4] = bf_lo(p.z); dst[5] = bf_hi(p.z); dst[6] = bf_lo(p.w); dst[7] = bf_hi(p.w); } while (0)
#define UNPKMUL8(dst, p, q) do { dst[0] = bf_lo(p.x) * bf_lo(q.x); dst[1] = bf_hi(p.x) * bf_hi(q.x); dst[2] = bf_lo(p.y) * bf_lo(q.y); dst[3] = bf_hi(p.y) * bf_hi(q.y); \
    dst[4] = bf_lo(p.z) * bf_lo(q.z); dst[5] = bf_hi(p.z) * bf_hi(q.z); dst[6] = bf_lo(p.w) * bf_lo(q.w); dst[7] = bf_hi(p.w) * bf_hi(q.w); } while (0)
#define LD8F(dst, ptr) do { const f32x4 _p = *(const f32x4*)(ptr), _q = *(const f32x4*)((ptr) + 4); dst[0] = _p.x; dst[1] = _p.y; dst[2] = _p.z; dst[3] = _p.w; dst[4] = _q.x; dst[5] = _q.y; dst[6] = _q.z; dst[7] = _q.w; } while (0)

__global__ void __launch_bounds__(512, 2) fwd_megakernel(Args a_unused) {
    extern __shared__ __attribute__((aligned(16))) unsigned char lds_raw[];
    cg::grid_group grid = cg::this_grid();
    LAS unsigned char* lds = (LAS unsigned char*)lds_raw;
    const int G = gridDim.x, NGW = G * 8, NGT = G * 512;
    const int wave_s = __builtin_amdgcn_readfirstlane((int)(threadIdx.x >> 6));
#define MY_TID() (wave_s * 64 + lane_id())
    volatile LAS unsigned* bst = (volatile LAS unsigned*)(lds + 131072 + 64);
    if (MY_TID() < 4) bst[MY_TID()] = 0u;
    if (MY_TID() == 0) ((volatile LAS int*)(lds + 131072 + 8192))[0] = -1;
    __syncthreads();
    XcdBarrier xbar;
    { KArgs* ap0 = (KArgs*)__builtin_amdgcn_kernarg_segment_ptr(); xbar = xcd_barrier_post((unsigned*)ap0->ws, bst); xbar.wave = wave_s; if (MY_TID() == 0) (void)xb_add(&xbar.bar[XB_XCNT(xbar.x)], 1u); }
    if (MY_TID() == 0) { unsigned* ctl = (unsigned*)((KArgs*)__builtin_amdgcn_kernarg_segment_ptr())->ws; bst[2] = xb_add(&ctl[3584 + 64 * xbar.x], 1u); }
#define LOCAL_BAR() do { if (xlocal) xcd_local_barrier(xbar); else xcd_barrier(xbar); } while (0)
#define GRID_BAR() do { for (int _r = 0; _r < REP_BAR; ++_r) xcd_barrier(xbar); } while (0)
#define PHASE_IDS() int tid = MY_TID(); asm volatile("" : "+v"(tid)); const int lane = tid & 63, wave = __builtin_amdgcn_readfirstlane(tid >> 6); const int gw = blockIdx.x * 8 + wave, gt = blockIdx.x * 512 + tid; (void)lane; (void)gw; (void)gt; (void)wave
#define PHASE_IDS_V() int tid = MY_TID(); asm volatile("" : "+v"(tid)); const int lane = tid & 63, wave = __builtin_amdgcn_readfirstlane(tid >> 6); const int gt = vb * 512 + tid; (void)lane; (void)wave
#define ARGS() KArgs* ap = (KArgs*)__builtin_amdgcn_kernarg_segment_ptr(); asm volatile("" : "+s"(ap)); unsigned char* ws = ap->ws; (void)ws

    {
        PHASE_IDS(); ARGS();
#define DECODE_ITEM(T, itv) do { const int _it = (itv); const int l = _it / PER_LAYER; int r = _it % PER_LAYER; unsigned char* wl = ws + WS_W + (size_t)l * LW; \
            const float* W; bf16_t* WT; const float* gs_ = nullptr; int K_, N_, k0, n0, drow0; \
            if (r < I_IN) { gs_ = ap->in[1] + (size_t)l * D; W = ap->in[2] + (size_t)l * D * NIN; WT = (bf16_t*)(wl + OW_IN); K_ = D; N_ = NIN; k0 = 64 * (r / (NIN / 32)); n0 = 32 * (r % (NIN / 32)); { const int sec_ = n0 >> 11, c0_ = n0 & 2047; drow0 = (sec_ == 3 || sec_ == 4) ? 256 * (24 + (c0_ >> 7)) + (c0_ & 127) + (sec_ == 4 ? 128 : 0) : ((sec_ >= 5) ? 256 * (40 + (c0_ >> 7)) + (c0_ & 127) + (sec_ == 6 ? 128 : 0) : n0); } } \
            else if ((r -= I_IN) < I_G) { const int which = r / 256, nb = (r / 32) & 7, kb = (r & 31) / 8, nblk = r & 7; \
                W = (which ? ap->in[8] : ap->in[6]) + (size_t)l * 8 * 256 * 256 + (size_t)nb * 256 * 256; WT = (bf16_t*)(wl + OW_G); K_ = 256; N_ = 256; k0 = 64 * kb; n0 = 32 * nblk; \
                const int c0 = nb * 256 + nblk * 32; drow0 = 256 * (c0 >> 7) + (c0 & 127) + (which ? 128 : 0); } \
            else if ((r -= I_G) < 3 * I_P) { const int w3 = r / I_P; r -= w3 * I_P; W = (w3 == 0 ? ap->in[12] : (w3 == 1 ? ap->in[13] : ap->in[14])) + (size_t)l * D * D; \
                WT = (bf16_t*)(wl + (w3 == 0 ? OW_PA : (w3 == 1 ? OW_PB : OW_O))); K_ = D; N_ = D; k0 = 64 * (r / (D / 32)); n0 = 32 * (r % (D / 32)); drow0 = n0; } \
            else if ((r -= 3 * I_P) < I_1) { gs_ = ap->in[15] + (size_t)l * D; W = ap->in[16] + (size_t)l * D * FF; WT = (bf16_t*)(wl + OW_1); K_ = D; N_ = FF; k0 = 64 * (r / (FF / 32)); n0 = 32 * (r % (FF / 32)); drow0 = n0; } \
            else { r -= I_1; W = ap->in[17] + (size_t)l * FF * D; WT = (bf16_t*)(wl + OW_2); K_ = FF; N_ = D; k0 = 64 * (r / (D / 32)); n0 = 32 * (r % (D / 32)); drow0 = n0; } \
            const int kg = lane >> 3, nl = lane & 7; \
            T.src = W + (size_t)(k0 + 8 * kg) * N_ + n0 + 4 * nl; T.dst = WT + (size_t)(drow0 + 4 * nl) * K_ + k0 + 8 * kg; T.gs = gs_ ? gs_ + k0 + 8 * kg : nullptr; T.N = N_; T.K = K_; } while (0)
#define STORE_ITEM(T, v) do { _Pragma("unroll") for (int j = 0; j < 4; ++j) { u32x4 o; o.x = cvt_pk_bf16(v[0][j], v[1][j]); o.y = cvt_pk_bf16(v[2][j], v[3][j]); o.z = cvt_pk_bf16(v[4][j], v[5][j]); o.w = cvt_pk_bf16(v[6][j], v[7][j]); \
            *(u32x4*)(T.dst + (size_t)j * T.K) = o; } } while (0)
        for (int rep = 0; rep < REP_P0; ++rep)
        for (int it = gw; it < DEPTH * PER_LAYER; it += 2 * NGW) {
            const bool has1 = (it + NGW) < DEPTH * PER_LAYER;
            TItem t0, t1; DECODE_ITEM(t0, it); DECODE_ITEM(t1, has1 ? it + NGW : it);
            f32x4 v0[8], v1[8];
#pragma unroll
            for (int i = 0; i < 8; ++i) v0[i] = __builtin_nontemporal_load((const f32x4*)(t0.src + (size_t)i * t0.N));
#pragma unroll
            for (int i = 0; i < 8; ++i) v1[i] = __builtin_nontemporal_load((const f32x4*)(t1.src + (size_t)i * t1.N));
            if (t0.gs) { float gq[8]; LD8F(gq, t0.gs);
#pragma unroll
                for (int i = 0; i < 8; ++i) v0[i] *= gq[i]; }
            if (t1.gs) { float gq[8]; LD8F(gq, t1.gs);
#pragma unroll
                for (int i = 0; i < 8; ++i) v1[i] *= gq[i]; }
            STORE_ITEM(t0, v0);
            if (has1) STORE_ITEM(t1, v1);
        }
        {
            const float* x = ap->in[0]; bf16_t* xb = (bf16_t*)(ws + WS_H); float* ss0 = (float*)(ws + WS_SSP);
            for (int m = gw; m < M; m += NGW) {
                const f32x4* xr = (const f32x4*)(x + (size_t)m * D) + lane;
                f32x4 v[8]; float sq = 0.f;
#pragma unroll
                for (int j = 0; j < 8; ++j) { v[j] = xr[64 * j]; sq += (v[j].x * v[j].x + v[j].y * v[j].y) + (v[j].z * v[j].z + v[j].w * v[j].w); }
                sq = wave_sum(sq);
                u32x2* o = (u32x2*)(xb + (size_t)m * D) + lane;
#pragma unroll
                for (int j = 0; j < 8; ++j) { u32x2 w; w.x = cvt_pk_bf16(v[j].x, v[j].y); w.y = cvt_pk_bf16(v[j].z, v[j].w); o[64 * j] = w; }
                if (lane < 8) ss0[(size_t)m * 8 + lane] = lane == 0 ? sq : 0.f;
            }
        }
        if (gt < DEPTH * D) { const float lv = ap->in[10][gt]; ((float*)(ws + WS_C8))[gt] = -8.0f * LOG2E * log1pf(__expf(-lv)); }
    }
    grid.sync();

    int vcu; bool xlocal;
    {
        unsigned* ctl = (unsigned*)((KArgs*)__builtin_amdgcn_kernarg_segment_ptr())->ws;
        bool even = (G % 8) == 0;
#pragma unroll
        for (int j = 0; j < 8; ++j) even = even && (xb_ld(&ctl[3584 + 64 * j]) == (unsigned)(G / 8));
        vcu = even ? (int)(bst[2] * 8u + xbar.x) : (int)blockIdx.x;
        vcu = __builtin_amdgcn_readfirstlane(vcu);
        xlocal = even;
    }
    const int vb = xlocal ? (vcu & 7) * (G >> 3) + (vcu >> 3) : (int)blockIdx.x;
#pragma unroll 1
    for (int l = 0; l < DEPTH; ++l) {
        {
            ARGS();
            pg8::Gemm g{(l == 0) ? (const bf16_t*)(ws + WS_H) : (const bf16_t*)ap->out + SEC, (const bf16_t*)(ws + WS_W + (size_t)l * LW + OW_IN), D, D, 0, 0, nullptr, nullptr}; pg8::StaticOrder S; S.init(M, NIN, G, vcu);
            EpiIn E{(bf16_t*)(ws + WS_Z), ap->in[3] + (size_t)l * NIN, (const float*)(ws + WS_SSP) + (size_t)(2 * l) * M * 8, 2 * l + 1, (LAS float*)(lds + 131072 + 8192)};
            for (int rep = 0; rep < REP_G1; ++rep) pg8::gemm_phase<EpiIn>(lds, g, S, E, wave_s);
        }
        GRID_BAR();
        {
            PHASE_IDS_V(); ARGS();
            bf16_t* Z = (bf16_t*)(ws + WS_Z); bf16_t* Hb = (bf16_t*)(ws + WS_H);
            const bf16_t* Zxa = Z; bf16_t* Zcb = Z + 2 * SEC; const bf16_t* Zp = Z + 3 * SEC;
            const float* caw = ap->in[4] + (size_t)l * 4 * D; const float* cab = ap->in[5] + (size_t)l * D; const float* cbw = ap->in[11] + (size_t)l * 3 * D;
            for (int item = gt; item < (M / 32) * (D / 8); item += NGT) {
                const int grp = item & 255, run = item >> 8, t0 = run * 32, c0 = grp * 8;
                const bool first = (t0 % SEQ) == 0;
                {
                    float w0[8], w1[8], w2[8], w3[8], bia[8];
                    LD8F(w0, caw + c0); LD8F(w1, caw + D + c0); LD8F(w2, caw + 2 * D + c0); LD8F(w3, caw + 3 * D + c0); LD8F(bia, cab + c0);
                    float x0[8], x1[8], x2[8];
#pragma unroll
                    for (int j = 0; j < 8; ++j) { x0[j] = 0.f; x1[j] = 0.f; x2[j] = 0.f; }
                    if (!first) {
                        const u32x4 p0 = *(const u32x4*)(Zxa + (size_t)(t0 - 3) * D + c0), p1 = *(const u32x4*)(Zxa + (size_t)(t0 - 2) * D + c0), p2 = *(const u32x4*)(Zxa + (size_t)(t0 - 1) * D + c0);
                        UNPK8(x0, p0); UNPK8(x1, p1); UNPK8(x2, p2);
                    }
                    u32x4 pa[8], pb[8];
#pragma unroll
                    for (int t = 0; t < 8; ++t) pa[t] = __builtin_nontemporal_load((const u32x4*)(Zxa + (size_t)(t0 + t) * D + c0));
#pragma unroll
                    for (int tb = 0; tb < 32; tb += 8) {
                        if (tb + 8 < 32) {
#pragma unroll
                            for (int t = 0; t < 8; ++t) pb[t] = __builtin_nontemporal_load((const u32x4*)(Zxa + (size_t)(t0 + tb + 8 + t) * D + c0));
                        }
#pragma unroll
                        for (int t = 0; t < 8; ++t) {
                            float xc[8]; UNPK8(xc, pa[t]);
                            float y[8];
#pragma unroll
                            for (int j = 0; j < 8; ++j) { y[j] = bia[j] + w0[j] * x0[j] + w1[j] * x1[j] + w2[j] * x2[j] + w3[j] * xc[j]; x0[j] = x1[j]; x1[j] = x2[j]; x2[j] = xc[j]; }
                            u32x4 o; o.x = cvt_pk_bf16(y[0], y[1]); o.y = cvt_pk_bf16(y[2], y[3]); o.z = cvt_pk_bf16(y[4], y[5]); o.w = cvt_pk_bf16(y[6], y[7]);
                            *(u32x4*)(Hb + (size_t)(t0 + tb + t) * D + c0) = o;
                        }
#pragma unroll
                        for (int t = 0; t < 8; ++t) pa[t] = pb[t];
                    }
                }
                {
                    float w0[8], w1[8], w2[8];
                    LD8F(w0, cbw + c0); LD8F(w1, cbw + D + c0); LD8F(w2, cbw + 2 * D + c0);
                    float x1[8], x2[8];
#pragma unroll
                    for (int j = 0; j < 8; ++j) { x1[j] = 0.f; x2[j] = 0.f; }
                    if (!first) {
                        const u32x4 p1 = *(const u32x4*)(Zp + (size_t)(t0 - 2) * D + c0), p2 = *(const u32x4*)(Zp + (size_t)(t0 - 1) * D + c0);
                        UNPK8(x1, p1); UNPK8(x2, p2);
                    }
#pragma unroll 1
                    for (int tb = 0; tb < 32; tb += 8) {
                        u32x4 pv[8], bv[8];
#pragma unroll
                        for (int t = 0; t < 8; ++t) { const size_t off = (size_t)(t0 + tb + t) * D + c0; pv[t] = __builtin_nontemporal_load((const u32x4*)(Zp + off)); bv[t] = __builtin_nontemporal_load((const u32x4*)(Zcb + off)); }
#pragma unroll
                        for (int t = 0; t < 8; ++t) {
                            float xc[8]; UNPK8(xc, pv[t]);
                            float cbv[8]; UNPK8(cbv, bv[t]);
                            float y[8];
#pragma unroll
                            for (int j = 0; j < 8; ++j) { y[j] = cbv[j] * (w0[j] * x1[j] + w1[j] * x2[j] + w2[j] * xc[j]); x1[j] = x2[j]; x2[j] = xc[j]; }
                            u32x4 o; o.x = cvt_pk_bf16(y[0], y[1]); o.y = cvt_pk_bf16(y[2], y[3]); o.z = cvt_pk_bf16(y[4], y[5]); o.w = cvt_pk_bf16(y[6], y[7]);
                            *(u32x4*)(Zcb + (size_t)(t0 + tb + t) * D + c0) = o;
                        }
                    }
                }
            }
        }
        LOCAL_BAR();
        {
            ARGS();
            pg8::Gemm g{(const bf16_t*)(ws + WS_H), (const bf16_t*)(ws + WS_W + (size_t)l * LW + OW_G), D, 256, 1, 256, nullptr, nullptr}; pg8::StaticOrder S; S.init(M, 2 * D, G, vcu);
            EpiGate E{(const bf16_t*)(ws + WS_H), (bf16_t*)(ws + WS_Z) + 4 * SEC, (bf16_t*)(ws + WS_B), ap->in[7] + (size_t)l * D, ap->in[9] + (size_t)l * D, (const float*)(ws + WS_C8) + (size_t)l * D};
            for (int rep = 0; rep < REP_G2; ++rep) pg8::gemm_phase<EpiGate>(lds, g, S, E, wave_s);
        }
        LOCAL_BAR();
        {
            PHASE_IDS_V(); ARGS();
            const bf16_t* Zxa = (const bf16_t*)(ws + WS_Z) + 4 * SEC; const bf16_t* Bb = (const bf16_t*)(ws + WS_B); float* AggA = (float*)(ws + WS_AGG); float* AggB = AggA + 256 * D;
            for (int rep = 0; rep < REP_S1; ++rep)
            for (int item = gt; item < (M / 64) * (D / 4); item += NGT) {
                const int grp = item & 511, chunk = item >> 9, t0 = chunk * 64, c0 = grp * 4;
                f32x4 h = {0.f, 0.f, 0.f, 0.f}, P = {0.f, 0.f, 0.f, 0.f};
#pragma unroll 8
                for (int t = 0; t < 64; ++t) {
                    const size_t off = (size_t)(t0 + t) * D + c0;
                    const u32x2 lw = *(const u32x2*)(Zxa + off), bw = *(const u32x2*)(Bb + off);
                    const f32x4 la = {bf_lo(lw.x), bf_hi(lw.x), bf_lo(lw.y), bf_hi(lw.y)}, bv = {bf_lo(bw.x), bf_hi(bw.x), bf_lo(bw.y), bf_hi(bw.y)};
                    f32x4 av; av.x = __builtin_amdgcn_exp2f(la.x); av.y = __builtin_amdgcn_exp2f(la.y); av.z = __builtin_amdgcn_exp2f(la.z); av.w = __builtin_amdgcn_exp2f(la.w);
                    h = av * h + bv; P += la;
                }
                f32x4 Av; Av.x = __builtin_amdgcn_exp2f(P.x); Av.y = __builtin_amdgcn_exp2f(P.y); Av.z = __builtin_amdgcn_exp2f(P.z); Av.w = __builtin_amdgcn_exp2f(P.w);
                *(f32x4*)(AggA + (size_t)chunk * D + c0) = Av; *(f32x4*)(AggB + (size_t)chunk * D + c0) = h;
            }
        }
        GRID_BAR();
        {
            PHASE_IDS_V(); ARGS();
            const bf16_t* Zxa = (const bf16_t*)(ws + WS_Z) + 4 * SEC; const bf16_t* Bb = (const bf16_t*)(ws + WS_B); const float* AggA = (const float*)(ws + WS_AGG); const float* AggB = AggA + 256 * D;
            const bf16_t* Zgy = (const bf16_t*)(ws + WS_Z) + SEC; bf16_t* Zhy = (bf16_t*)(ws + WS_Z) + 3 * SEC;
            for (int rep = 0; rep < REP_S3; ++rep)
            for (int item = gt; item < (M / 64) * (D / 4); item += NGT) {
                const int grp = item & 511, chunk = item >> 9, t0 = chunk * 64, c0 = grp * 4;
                const int cfirst = chunk & ~63;
                f32x4 h = {0.f, 0.f, 0.f, 0.f};
#pragma unroll 1
                for (int cb8 = cfirst; cb8 < chunk; cb8 += 8) {
                    f32x4 Av[8], Bv[8];
#pragma unroll
                    for (int k = 0; k < 8; ++k) { Av[k] = *(const f32x4*)(AggA + (size_t)(cb8 + k) * D + c0); Bv[k] = *(const f32x4*)(AggB + (size_t)(cb8 + k) * D + c0); }
#pragma unroll
                    for (int k = 0; k < 8; ++k) { const bool use = (cb8 + k) < chunk; const f32x4 hn = Av[k] * h + Bv[k]; h = use ? hn : h; }
                }
#pragma unroll 1
                for (int tb = 0; tb < 64; tb += 8) {
                    u32x2 lw[8], bw[8], gv[8];
#pragma unroll
                    for (int t = 0; t < 8; ++t) { const size_t off = (size_t)(t0 + tb + t) * D + c0; lw[t] = __builtin_nontemporal_load((const u32x2*)(Zxa + off)); bw[t] = __builtin_nontemporal_load((const u32x2*)(Bb + off)); gv[t] = __builtin_nontemporal_load((const u32x2*)(Zgy + off)); }
#pragma unroll
                    for (int t = 0; t < 8; ++t) {
                        const f32x4 la = {bf_lo(lw[t].x), bf_hi(lw[t].x), bf_lo(lw[t].y), bf_hi(lw[t].y)}, bv = {bf_lo(bw[t].x), bf_hi(bw[t].x), bf_lo(bw[t].y), bf_hi(bw[t].y)};
                        const f32x4 gy = {gelu_tanh(bf_lo(gv[t].x)), gelu_tanh(bf_hi(gv[t].x)), gelu_tanh(bf_lo(gv[t].y)), gelu_tanh(bf_hi(gv[t].y))};
                        f32x4 av; av.x = __builtin_amdgcn_exp2f(la.x); av.y = __builtin_amdgcn_exp2f(la.y); av.z = __builtin_amdgcn_exp2f(la.z); av.w = __builtin_amdgcn_exp2f(la.w);
                        h = av * h + bv;
                        const f32x4 y = h * gy;
                        u32x2 o; o.x = cvt_pk_bf16(y.x, y.y); o.y = cvt_pk_bf16(y.z, y.w);
                        *(u32x2*)(Zhy + (size_t)(t0 + tb + t) * D + c0) = o;
                    }
                }
            }
        }
        LOCAL_BAR();
        {
            ARGS();
            bf16_t* Z = (bf16_t*)(ws + WS_Z);
            pg8::StaticOrder S; S.init(M, D, G, vcu);
            pg8::Gemm g{Z + 3 * SEC, (const bf16_t*)(ws + WS_W + (size_t)l * LW + OW_PA), D, D, 0, 0, Z + 2 * SEC, (const bf16_t*)(ws + WS_W + (size_t)l * LW + OW_PB)};
            EpiMerge2 E{Z + 5 * SEC, Z + 6 * SEC};
            pg8::gemm_phase<EpiMerge2, 2>(lds, g, S, E, wave_s);
        }
        LOCAL_BAR();
        {
            ARGS();
            pg8::Gemm g{(const bf16_t*)(ws + WS_Z) + 5 * SEC, (const bf16_t*)(ws + WS_W + (size_t)l * LW + OW_O), D, D, 0, 0, nullptr, nullptr}; pg8::StaticOrder S; S.init(M, D, G, vcu);
            bf16_t* R1 = (l + 1 == DEPTH) ? (bf16_t*)(ws + WS_H) : (bf16_t*)ap->out; bf16_t* R2 = (bf16_t*)ap->out + SEC;
            EpiResid E{(l == 0) ? (const void*)ap->in[0] : (const void*)R2, (void*)R1, (float*)(ws + WS_SSP) + (size_t)(2 * l + 1) * M * 8, l != 0, false, (LAS float*)(lds + 131072 + 1024)};
            pg8::gemm_phase<EpiResid>(lds, g, S, E, wave_s);
        }
        LOCAL_BAR();
        {
            ARGS();
            pg8::Gemm g{(l + 1 == DEPTH) ? (const bf16_t*)(ws + WS_H) : (const bf16_t*)ap->out, (const bf16_t*)(ws + WS_W + (size_t)l * LW + OW_1), D, D, 0, 0, nullptr, nullptr}; pg8::StaticOrder S; S.init(M, FF, G, vcu);
            EpiRelu2 E{(bf16_t*)(ws + WS_Z), (const float*)(ws + WS_SSP) + (size_t)(2 * l + 1) * M * 8, 2 * l + 2, (LAS float*)(lds + 131072 + 8192)};
            for (int rep = 0; rep < REP_G6; ++rep) pg8::gemm_phase<EpiRelu2>(lds, g, S, E, wave_s);
        }
        LOCAL_BAR();
        if (l + 1 < DEPTH) {
            ARGS();
            pg8::Gemm g{(const bf16_t*)(ws + WS_Z), (const bf16_t*)(ws + WS_W + (size_t)l * LW + OW_2), FF, FF, 0, 0, nullptr, nullptr}; pg8::StaticOrder S; S.init(M, D, G, vcu); S.revr = true;
            bf16_t* R1 = (bf16_t*)ap->out; bf16_t* R2 = R1 + SEC;
            EpiResid E{(const void*)R1, (void*)R2, (float*)(ws + WS_SSP) + (size_t)(2 * l + 2) * M * 8, true, false, (LAS float*)(lds + 131072 + 1024)};
            pg8::gemm_phase<EpiResid>(lds, g, S, E, wave_s);
            LOCAL_BAR();
        } else {
            ARGS();
            pg8::Gemm g{(const bf16_t*)(ws + WS_Z), (const bf16_t*)(ws + WS_W + (size_t)l * LW + OW_2), FF, FF, 0, 0, nullptr, nullptr}; pg8::StaticOrder S; S.init(M, D, G, vcu, true); S.revr = true;
            EpiFinal E{(const bf16_t*)(ws + WS_H), ap->out, (float*)(ws + WS_SSP) + (size_t)4 * M * 8, ap->in[18], (LAS float*)(lds + 131072 + 1024), xbar, xlocal};
            pg8::gemm_phase<EpiFinal>(lds, g, S, E, wave_s);
        }
    }
}

extern "C" void kernel_launch(void* const* d_in, const int* in_sizes, int n_in, void* d_out, int out_size, void* d_ws, size_t ws_size, hipStream_t stream) {
    static int grid = 0;
    if (grid == 0) {
        if (n_in != 19 || out_size != M * D || ws_size < WS_END) { fprintf(stderr, "kernel_launch: unexpected shapes n_in %d out %d ws %zu\n", n_in, out_size, ws_size); grid = -1; return; }
        int dev = 0, cus = 0, per_cu = 0;
        hipGetDevice(&dev); hipDeviceGetAttribute(&cus, hipDeviceAttributeMultiprocessorCount, dev);
        if (hipFuncSetAttribute((const void*)fwd_megakernel, hipFuncAttributeMaxDynamicSharedMemorySize, LDS_BYTES) != hipSuccess) { fprintf(stderr, "kernel_launch: hipFuncSetAttribute failed\n"); grid = -1; return; }
        if (hipOccupancyMaxActiveBlocksPerMultiprocessor(&per_cu, (const void*)fwd_megakernel, 512, LDS_BYTES) != hipSuccess || per_cu < 1) { fprintf(stderr, "kernel_launch: occupancy query says %d\n", per_cu); per_cu = 1; }
        (void)hipGetLastError();
        grid = cus * 1;
    }
    if (grid < 0) return;
    if (hipMemsetAsync(d_ws, 0, 65536, stream) != hipSuccess) { fprintf(stderr, "kernel_launch: memset failed\n"); return; }
    Args a{};
    for (int i = 0; i < 19; ++i) a.in[i] = (const float*)d_in[i];
    a.out = (float*)d_out; a.ws = (unsigned char*)d_ws;
    void* args[] = {&a};
    hipError_t e = hipLaunchCooperativeKernel((const void*)fwd_megakernel, dim3(grid), dim3(512), args, LDS_BYTES, stream);
    if (e != hipSuccess) fprintf(stderr, "cooperative launch failed: %s (grid %d)\n", hipGetErrorString(e), grid);
}
```
